# Optimizing an MI355X kernel written in HIP

```python
import math
import jax, jax.numpy as jnp
from jax import lax
import numpy as np

D_MODEL = 1024
BATCH = 32
SEQ = 256
DEPTH = 1
DEC_BATCH = 2
DEC_SEQ = 4096
PAST_LEN = 256

GRID_W = 64
D_A = D_MODEL
H_A = 8
DK = D_A // H_A
DV = D_A // H_A
CHUNK = 32
D_B = D_MODEL
SHORT_W = 3
FILT_EMB = 33
FILT_BANDS = (FILT_EMB - 1) // 2
FILT_ORDER = 64
DECAY_FAST = 0.3
DECAY_SLOW = 1.5
DECAY_TARGET = 1e-2
DECAY_SHIFT = 0.05
D_FF = ((8 * D_MODEL // 3 + 255) // 256) * 256
N_MOD = 6
W_IN_COLS = 5 * D_A + 3 * D_B + 2 * D_MODEL
SPLIT_IDX = (D_A, 2 * D_A, 3 * D_A, 4 * D_A, 5 * D_A, 5 * D_A + 3 * D_B)
ALPHA = (2.0 * DEPTH) ** 0.25
BETA = (8.0 * DEPTH) ** -0.25
LN_EPS = 1e-5
RMS_EPS = 1e-6

kernel_name = "hybrid_hgrn2_hyena_prefix_dit_step"


def layer_norm(x, g, b):
    xf = x.astype(jnp.float32)
    mu = xf.mean(-1, keepdims=True)
    var = jnp.square(xf - mu).mean(-1, keepdims=True)
    return ((xf - mu) * lax.rsqrt(var + LN_EPS) * g.astype(jnp.float32) + b.astype(jnp.float32)).astype(x.dtype)


def hgrn_chunk_scan(q, k, v, logf, s0):
    bsz, L = q.shape[0], q.shape[1]
    n = L // CHUNK
    q = q.reshape(bsz, n, CHUNK, H_A, DK)
    k = k.reshape(bsz, n, CHUNK, H_A, DK)
    v = v.reshape(bsz, n, CHUNK, H_A, DV)
    b = jnp.cumsum(logf.reshape(bsz, n, CHUNK, H_A, DK), axis=2)
    b_last = b[:, :, -1:]
    q_in = q * jnp.exp(b)
    k_in = k * jnp.exp(-b)
    mask = jnp.tril(jnp.ones((CHUNK, CHUNK), dtype=bool))
    scores = jnp.where(mask, jnp.einsum('bncha,bnsha->bnhcs', q_in, k_in), 0.0)
    o_intra = jnp.einsum('bnhcs,bnshv->bnchv', scores, v)
    k_st = k * jnp.exp(b_last - b)
    u = jnp.einsum('bncha,bnchv->bnhav', k_st, v)
    decay = jnp.exp(b_last[:, :, 0])

    def step(s, inp):
        dec, du = inp
        return dec[..., None] * s + du, s

    s_final, s_starts = lax.scan(step, s0, (jnp.moveaxis(decay, 1, 0), jnp.moveaxis(u, 1, 0)))
    s_starts = jnp.moveaxis(s_starts, 0, 1)
    o_inter = jnp.einsum('bncha,bnhav->bnchv', q_in, s_starts)
    return (o_intra + o_inter).reshape(bsz, L, H_A, DV), s_final


def hgrn2_mixer(q_raw, f_fwd, f_bwd, i_raw, g_raw, lb, norm_w, s0_fwd, s0_bwd):
    f32 = jnp.float32
    bsz, L, _ = q_raw.shape

    def heads(t):
        return t.astype(f32).reshape(bsz, L, H_A, -1)

    q = heads(jax.nn.silu(q_raw.astype(f32)))
    v = heads(i_raw)

    def gates(z, lb_d):
        fg = lb_d + (1.0 - lb_d) * jax.nn.sigmoid(z.astype(f32))
        return heads(1.0 - fg), heads(jnp.log(fg))

    k_f, lf_f = gates(f_fwd, lb[0])
    k_b, lf_b = gates(f_bwd, lb[1])
    flip = lambda t: jnp.flip(t, axis=1)
    o_f, s_f = hgrn_chunk_scan(q, k_f, v, lf_f, s0_fwd.astype(f32))
    o_b, s_b = hgrn_chunk_scan(flip(q), flip(k_b), flip(v), flip(lf_b), s0_bwd.astype(f32))
    o = o_f + flip(o_b)
    o = o * lax.rsqrt(jnp.mean(jnp.square(o), axis=-1, keepdims=True) + RMS_EPS) * norm_w.astype(f32)
    o = o.reshape(bsz, L, D_A) * jax.nn.silu(g_raw.astype(f32))
    return o.astype(q_raw.dtype), s_f, s_b


def short_conv(u, w, b, row_len):
    bsz, L, ch = u.shape
    n_rows = L // row_len
    u4 = u.reshape(bsz, n_rows, row_len, ch)
    up = jnp.pad(u4, ((0, 0), (0, 0), (1, 1), (0, 0)))
    y = up[:, :, :-2] * w[0] + up[:, :, 1:-1] * w[1] + up[:, :, 2:] * w[2] + b
    return y.reshape(bsz, L, ch)


def hyena_filters(L, w1, b1, w2, b2, w3, b3, freq, w4):
    f32 = jnp.float32
    t = jnp.linspace(0.0, 1.0, L, dtype=f32)[:, None]
    wpos = (2.0 * math.pi / L) * jnp.arange(L, dtype=f32)[:, None]
    bands = jnp.linspace(1e-4, FILT_BANDS - 1, FILT_BANDS, dtype=f32)[None, :]
    z = jnp.concatenate([t, jnp.cos(bands * wpos), -jnp.sin(bands * wpos)], axis=-1)
    freq = freq.astype(f32)
    h = jnp.sin(freq[0] * (z @ w1.astype(f32) + b1.astype(f32)))
    h = jnp.sin(freq[1] * (h @ w2.astype(f32) + b2.astype(f32)))
    h = jnp.sin(freq[2] * (h @ w3.astype(f32) + b3.astype(f32)))
    h = h @ w4.astype(f32)
    max_decay = math.log(DECAY_TARGET) / DECAY_FAST
    min_decay = math.log(DECAY_TARGET) / DECAY_SLOW
    deltas = jnp.linspace(min_decay, max_decay, D_B, dtype=f32)
    window = jnp.exp(-t * jnp.abs(deltas)) + DECAY_SHIFT
    h = h.reshape(L, 2, D_B) * window[:, None, :]
    return h[:, 0], h[:, 1]


def long_conv(u, h_fwd, h_bwd, skip):
    f32 = jnp.float32
    L = u.shape[1]
    kern = jnp.concatenate([h_fwd, jnp.zeros((1, D_B), f32), jnp.flip(h_bwd[1:], axis=0)], axis=0)
    uf = u.astype(f32)
    U = jnp.fft.rfft(uf, n=2 * L, axis=1)
    K = jnp.fft.rfft(kern, n=2 * L, axis=0)
    y = jnp.fft.irfft(U * K[None], n=2 * L, axis=1)[:, :L]
    return (y + uf * skip.astype(f32)).astype(u.dtype)


def hyena_mixer(u, p, row_len):
    u = short_conv(u, p['hy_conv_w'], p['hy_conv_b'], row_len)
    x0, x1, v = jnp.split(u, 3, axis=-1)
    h_f, h_b = hyena_filters(u.shape[1], p['filt_w1'], p['filt_b1'], p['filt_w2'], p['filt_b2'],
                             p['filt_w3'], p['filt_b3'], p['filt_freq'], p['filt_w4'])
    return x0 * long_conv(v * x1, h_f, h_b, p['hy_skip'])


def trunk_layer(x, cond, row_len, s0_fwd, s0_bwd, lb, p):
    mod = (jax.nn.silu(cond) @ p['ada_w'] + p['ada_b']).reshape(cond.shape[0], N_MOD, D_MODEL)
    shift1, scale1, gate1 = mod[:, None, 0], mod[:, None, 1], mod[:, None, 2]
    shift2, scale2, gate2 = mod[:, None, 3], mod[:, None, 4], mod[:, None, 5]

    h = x * (1.0 + scale1) + shift1
    proj = h @ p['w_in']
    q, f_fwd, f_bwd, i_raw, g_raw, hy, mg = jnp.split(proj, SPLIT_IDX, axis=-1)
    o_a, s_f, s_b = hgrn2_mixer(q, f_fwd, f_bwd, i_raw, g_raw, lb, p['hgrn_norm_w'], s0_fwd, s0_bwd)
    o_b = hyena_mixer(hy, p, row_len)
    gate_a, gate_b = jnp.split(jax.nn.sigmoid(mg), 2, axis=-1)
    mix = (gate_a * (o_a @ p['proj_a']) + gate_b * (o_b @ p['proj_b'])) @ p['w_out']
    x = layer_norm(ALPHA * x + gate1 * mix, p['ln1_g'], p['ln1_b'])

    h = x * (1.0 + scale2) + shift2
    gt, up = jnp.split(h @ p['ffn_w_in'], 2, axis=-1)
    ff = (jax.nn.silu(gt) * up) @ p['ffn_w_out']
    x = layer_norm(ALPHA * x + gate2 * ff, p['ln2_g'], p['ln2_b'])
    return x, s_f, s_b


def setup_inputs(seed: int = 0) -> dict:
    key = jax.random.key(seed)
    ks = jax.random.split(key, 32)
    f32 = jnp.float32

    def nrm(k, shape, scale):
        return jax.random.normal(k, shape, f32) * scale

    return {
        "x_prompt": nrm(ks[0], (BATCH, SEQ, D_MODEL), 1.0),
        "x_sample": nrm(ks[1], (DEC_BATCH, DEC_SEQ, D_MODEL), 1.0),
        "state_hgrn": nrm(ks[2], (DEC_BATCH, DEPTH, 2, H_A, DK, DV), 0.5),
        "c": nrm(ks[3], (DEC_BATCH, D_MODEL), 1.0),
        "c_ctx": nrm(ks[4], (D_MODEL,), 1.0),
        "ada_w": nrm(ks[5], (DEPTH, D_MODEL, N_MOD * D_MODEL), 0.5 * D_MODEL ** -0.5),
        "ada_b": nrm(ks[6], (DEPTH, N_MOD * D_MODEL), 0.02),
        "w_in": nrm(ks[7], (DEPTH, D_MODEL, W_IN_COLS), D_MODEL ** -0.5),
        "hgrn_lb_logits": nrm(ks[8], (DEPTH + 1, 2, D_A), 0.1),
        "hgrn_norm_w": 1.0 + nrm(ks[9], (DEPTH, DV), 0.05),
        "hy_conv_w": nrm(ks[10], (DEPTH, SHORT_W, 3 * D_B), SHORT_W ** -0.5),
        "hy_conv_b": nrm(ks[11], (DEPTH, 3 * D_B), 0.02),
        "filt_w1": nrm(ks[12], (DEPTH, FILT_EMB, FILT_ORDER), FILT_EMB ** -0.5),
        "filt_b1": nrm(ks[13], (DEPTH, FILT_ORDER), 0.1),
        "filt_w2": nrm(ks[14], (DEPTH, FILT_ORDER, FILT_ORDER), FILT_ORDER ** -0.5),
        "filt_b2": nrm(ks[15], (DEPTH, FILT_ORDER), 0.1),
        "filt_w3": nrm(ks[16], (DEPTH, FILT_ORDER, FILT_ORDER), FILT_ORDER ** -0.5),
        "filt_b3": nrm(ks[17], (DEPTH, FILT_ORDER), 0.1),
        "filt_freq": 1.0 + nrm(ks[18], (DEPTH, 3, FILT_ORDER), 0.05),
        "filt_w4": nrm(ks[19], (DEPTH, FILT_ORDER, 2 * D_B), FILT_ORDER ** -0.5),
        "hy_skip": nrm(ks[20], (DEPTH, D_B), 0.5),
        "proj_a": nrm(ks[21], (DEPTH, D_A, D_MODEL), D_A ** -0.5),
        "proj_b": nrm(ks[22], (DEPTH, D_B, D_MODEL), D_B ** -0.5),
        "w_out": nrm(ks[23], (DEPTH, D_MODEL, D_MODEL), BETA * D_MODEL ** -0.5),
        "ln1_g": 1.0 + nrm(ks[24], (DEPTH, D_MODEL), 0.05),
        "ln1_b": nrm(ks[25], (DEPTH, D_MODEL), 0.02),
        "ffn_w_in": nrm(ks[26], (DEPTH, D_MODEL, 2 * D_FF), D_MODEL ** -0.5),
        "ffn_w_out": nrm(ks[27], (DEPTH, D_FF, D_MODEL), BETA * D_FF ** -0.5),
        "ln2_g": 1.0 + nrm(ks[28], (DEPTH, D_MODEL), 0.05),
        "ln2_b": nrm(ks[29], (DEPTH, D_MODEL), 0.02),
    }


def reference(x_prompt, x_sample, state_hgrn, c, c_ctx, ada_w, ada_b, w_in, hgrn_lb_logits, hgrn_norm_w,
              hy_conv_w, hy_conv_b, filt_w1, filt_b1, filt_w2, filt_b2, filt_w3, filt_b3, filt_freq, filt_w4,
              hy_skip, proj_a, proj_b, w_out, ln1_g, ln1_b, ffn_w_in, ffn_w_out, ln2_g, ln2_b):
    lb_all = jnp.cumsum(jax.nn.softmax(hgrn_lb_logits.astype(jnp.float32), axis=0), axis=0)
    ctx_len = x_prompt.shape[1]
    rows = x_sample.shape[1] // GRID_W
    lat_row_len = x_sample.shape[1] // rows
    zero_state = jnp.zeros((x_prompt.shape[0], H_A, DK, DV), jnp.float32)
    y_prompt = x_prompt
    y_sample = x_sample
    ctx_states = []
    for l in range(DEPTH):
        p = dict(ada_w=ada_w[l], ada_b=ada_b[l], w_in=w_in[l], hgrn_norm_w=hgrn_norm_w[l],
                 hy_conv_w=hy_conv_w[l], hy_conv_b=hy_conv_b[l], filt_w1=filt_w1[l], filt_b1=filt_b1[l],
                 filt_w2=filt_w2[l], filt_b2=filt_b2[l], filt_w3=filt_w3[l], filt_b3=filt_b3[l],
                 filt_freq=filt_freq[l], filt_w4=filt_w4[l], hy_skip=hy_skip[l], proj_a=proj_a[l],
                 proj_b=proj_b[l], w_out=w_out[l], ln1_g=ln1_g[l], ln1_b=ln1_b[l],
                 ffn_w_in=ffn_w_in[l], ffn_w_out=ffn_w_out[l], ln2_g=ln2_g[l], ln2_b=ln2_b[l])
        lb = lb_all[l]
        y_prompt, s_f, s_b = trunk_layer(y_prompt, c_ctx[None, :], ctx_len, zero_state, zero_state, lb, p)
        ctx_states.append(jnp.stack([s_f, s_b], axis=1).astype(x_prompt.dtype))
        y_sample, _, _ = trunk_layer(y_sample, c, lat_row_len, state_hgrn[:, l, 0], state_hgrn[:, l, 1], lb, p)
    new_state_hgrn = jnp.stack(ctx_states, axis=1)
    return (y_prompt, y_sample, new_state_hgrn)
```

```cpp
#include <hip/hip_runtime.h>
#include <hip/hip_cooperative_groups.h>
#include <cstdio>
namespace cg = cooperative_groups;

#define CONV_REP_MAIN 1
#ifndef SPLIT_LAUNCH
#define SPLIT_LAUNCH 0
#endif

#define LAS __attribute__((address_space(3)))
typedef unsigned short u16;
typedef short bf16x8 __attribute__((ext_vector_type(8)));
typedef short bf16x4 __attribute__((ext_vector_type(4)));
typedef float f32x4 __attribute__((ext_vector_type(4)));
typedef float f32x16 __attribute__((ext_vector_type(16)));
typedef unsigned u32x4 __attribute__((ext_vector_type(4)));
typedef unsigned u32x2 __attribute__((ext_vector_type(2)));
typedef _Float16 h16x2 __attribute__((ext_vector_type(2)));

constexpr int T = 16384, D = 1024, NIN = 10240, DFF = 2816, NMOD = 6144;
constexpr size_t MiB = 1u << 20;
constexpr int LDS_BYTES = 155648 + 64;
constexpr int LDS_XB_OFF = 155648;
constexpr float ALPHA = 1.189207115002721f;

constexpr size_t WS_WIN = 0, WS_WPA = 20 * MiB, WS_WPB = 22 * MiB, WS_WOUT = 24 * MiB;
constexpr size_t WS_MISC = 26 * MiB;
constexpr size_t WS_MOD = WS_MISC, WS_LB = WS_MISC + 128 * 1024, WS_H3P = WS_MISC + 256 * 1024, WS_H3S = WS_MISC + 512 * 1024, WS_SEGD = WS_MISC + 1536 * 1024, WS_BAR = WS_MISC + 1792 * 1024;
constexpr size_t WS_HB = 28 * MiB;
constexpr size_t WS_R60 = 60 * MiB;
constexpr size_t WS_Q = 60 * MiB, WS_LFF = 92 * MiB, WS_LFB = 124 * MiB, WS_V = 156 * MiB, WS_G = 188 * MiB, WS_GA = 220 * MiB;
constexpr size_t WS_T1 = 60 * MiB, WS_U1 = 92 * MiB, WS_X1 = 156 * MiB, WS_FF = 60 * MiB, WS_WFIN = 220 * MiB, WS_WFOUT = 232 * MiB;

struct Params { const float* in[30]; float* out; unsigned char* ws; int ph_lo, ph_hi; };

struct Ctx {
    const float* in[30]; float* out; unsigned char* ws;
    __device__ __forceinline__ const float* xrow(int tok) const { return tok < 8192 ? in[0] + (size_t)tok * D : in[1] + (size_t)(tok - 8192) * D; }
};
__device__ __forceinline__ int cid_of(int tok) { return tok < 8192 ? 0 : 1 + ((tok - 8192) >> 12); }

typedef __bf16 bf16v2 __attribute__((ext_vector_type(2)));
typedef float f32x2 __attribute__((ext_vector_type(2)));
__device__ __forceinline__ unsigned cvt_pk_bf16(float lo, float hi) { f32x2 v = {lo, hi}; bf16v2 b = __builtin_convertvector(v, bf16v2); return __builtin_bit_cast(unsigned, b); }
__device__ __forceinline__ float bf2f(u16 b) { return __uint_as_float(((unsigned)b) << 16); }
__device__ __forceinline__ float bflo(unsigned w) { return __uint_as_float(w << 16); }
__device__ __forceinline__ float bfhi(unsigned w) { return __uint_as_float(w & 0xffff0000u); }
__device__ __forceinline__ u16 f2bf(float f) { return (u16)(cvt_pk_bf16(f, 0.f) & 0xffffu); }
__device__ __forceinline__ float sigmoid_f(float x) { return __builtin_amdgcn_rcpf(1.f + __expf(-x)); }
__device__ __forceinline__ float silu_f(float x) { return x * __builtin_amdgcn_rcpf(1.f + __expf(-x)); }
__device__ __forceinline__ float red2pi(float x) { const float k = rintf(x * 0.15915494309189535f); float r = fmaf(-k, 6.2831854820251465f, x); return fmaf(k, 1.7484555e-7f, r); }
__device__ __forceinline__ float my_sin(float x) { return __sinf(red2pi(x)); }
__device__ __forceinline__ float my_cos(float x) { return __cosf(red2pi(x)); }
__device__ __forceinline__ int rowmap(int reg, int hh) { return (reg & 3) + 8 * (reg >> 2) + 4 * hh; }
__device__ __forceinline__ f32x16 mfma32(bf16x8 a, bf16x8 b, f32x16 c) { return __builtin_amdgcn_mfma_f32_32x32x16_bf16(a, b, c, 0, 0, 0); }
__device__ __forceinline__ bf16x8 pack8(float a0, float a1, float a2, float a3, float a4, float a5, float a6, float a7) {
    u32x4 w; w.x = cvt_pk_bf16(a0, a1); w.y = cvt_pk_bf16(a2, a3); w.z = cvt_pk_bf16(a4, a5); w.w = cvt_pk_bf16(a6, a7);
    return __builtin_bit_cast(bf16x8, w);
}

namespace pg8 {
constexpr int BM = 256, BK = 64, HALF = 128, HTB = HALF * BK * 2, STAGE_BYTES = 8 * HTB, NXCD = 8, WGM = 4;
__device__ __forceinline__ int lds_byte(int r, int c) { const int st = (r >> 4) * 2 + (c >> 5), rr = r & 15, cc = c & 31, ob = rr * 64 + cc * 2; return st * 1024 + (ob ^ (((ob >> 9) & 1) << 5)); }
__device__ __forceinline__ void stage_rc(int b, int& R, int& C) { const int st = b / 1024, sb = b % 1024, swz = sb ^ (((sb >> 9) & 1) << 5); R = (st >> 1) * 16 + swz / 64; C = (st & 1) * 32 + (swz % 64) / 2; }
__device__ __forceinline__ int perm32(int rho) { const int n = rho >> 4, i = rho & 15; return 8 * (i >> 2) + 4 * n + (i & 3); }

struct Unit { const char* A; const char* B; int pm, pn, aux, pad; };
struct Gemm { int K; size_t hstepA, hstepB; };

struct Sched {
    int nM, nN, nwg, G, c, kind;
    const char* A; const char* B; const char* A2; const char* B2; size_t tsA, tsB;
    __device__ __forceinline__ void map(int wgid, int& pm, int& pn) const {
        { const int q = nwg / NXCD, r = nwg % NXCD, xcd = wgid % NXCD, off = wgid / NXCD; wgid = (xcd < r ? xcd * (q + 1) : r * (q + 1) + (xcd - r) * q) + off; }
        const int nig = WGM * nN, gid = wgid / nig, fm = gid * WGM, gsz = (nM - fm) < WGM ? (nM - fm) : WGM;
        pm = fm + ((wgid % nig) % gsz); pn = (wgid % nig) / gsz;
    }
    __device__ __forceinline__ bool next(int i, Unit& u) const {
        if (kind == 2) {
            const long L = (long)(i >> 1) * G + c; if (L >= nwg) return false;
            int pm, pn; map((int)L, pm, pn); u.pm = pm; u.pn = pn; u.aux = i & 1; u.pad = 0;
            u.A = ((i & 1) ? A2 : A) + (size_t)pm * tsA; u.B = ((i & 1) ? B2 : B) + (size_t)pn * tsB; return true;
        }
        const long L = (long)i * G + c; if (L >= nwg) return false;
        int pm, pn; map((int)L, pm, pn); u.pm = pm; u.pn = pn; u.aux = 0; u.pad = 0;
        u.A = A + (size_t)pm * tsA;
        if (kind == 1) { const int seg = pn >> 2; const int rows = (seg < 5 ? seg * 1024 : 8192 + (seg - 5) * 1024) + (pn & 3) * 256; u.B = B + (size_t)rows * (D * 2); }
        else u.B = B + (size_t)pn * tsB;
        return true;
    }
};

template <class Epi, bool ALIGN_EPI = true, bool SP2 = true>
__device__ __forceinline__ void gemm_phase(LAS unsigned char* lds, const Gemm g, const Sched& S, const Epi& E) {
    const int tid = threadIdx.x, wid = __builtin_amdgcn_readfirstlane(tid >> 6), lane = tid & 63, wr = wid >> 2, wc = wid & 3, fr = lane & 15, fq = lane >> 4;
    const int K = g.K, nt = K / BK;
    unsigned voffA[2], voffB[2];
#pragma unroll
    for (int i = 0; i < 2; ++i) { int R, C; stage_rc(tid * 16 + i * 8192, R, C); const int Rb = (R & ~31) + perm32(R & 31);
        voffA[i] = (unsigned)(R * K + C) * 2u; voffB[i] = (unsigned)(Rb * K + C) * 2u; }
    const size_t kstep = (size_t)(BK * 2);
    const size_t hsA = g.hstepA, hsB = g.hstepB;
    const unsigned ldsw = (unsigned)wid * 1024u;
    const int aoff = lds_byte(wr * 64 + fr, fq * 8), boff = lds_byte(wc * 32 + fr, fq * 8);
#define PG8_SA(b, h) (((b) * 2 + (h)) * HTB)
#define PG8_SB(b, h) ((4 + (b) * 2 + (h)) * HTB)
#define PG8_STAGE(bufoff, gbase, voff) do { _Pragma("unroll") for (int _i = 0; _i < 2; ++_i) \
        __builtin_amdgcn_global_load_lds((const unsigned*)((const char*)(gbase) + (voff)[_i]), (LAS unsigned*)(lds + (bufoff) + ldsw + _i * 8192), 16, 0, 0); } while (0)
#define PG8_LDA(dst, b, h) do { _Pragma("unroll") for (int m = 0; m < 4; ++m) _Pragma("unroll") for (int k = 0; k < 2; ++k) dst[m][k] = *(const LAS bf16x8*)(lds + PG8_SA(b, h) + aoff + m * 2048 + k * 1024); } while (0)
#define PG8_LDB(dst, b, h) do { _Pragma("unroll") for (int n = 0; n < 2; ++n) _Pragma("unroll") for (int k = 0; k < 2; ++k) dst[n][k] = *(const LAS bf16x8*)(lds + PG8_SB(b, h) + boff + n * 2048 + k * 1024); } while (0)
#define PG8_MMA(ai, bj, At, Bt) do { __builtin_amdgcn_s_setprio(1); _Pragma("unroll") for (int m = 0; m < 4; ++m) _Pragma("unroll") for (int n = 0; n < 2; ++n) _Pragma("unroll") for (int k = 0; k < 2; ++k) \
        acc[ai][bj][m][n] = __builtin_amdgcn_mfma_f32_16x16x32_bf16(Bt[n][k], At[m][k], acc[ai][bj][m][n], 0, 0, 0); __builtin_amdgcn_s_setprio(0); } while (0)
#define PG8_WAIT_V(n) asm volatile("s_waitcnt vmcnt(" #n ")" ::: "memory")
#define PG8_WAIT_L(n) asm volatile("s_waitcnt lgkmcnt(" #n ")" ::: "memory")
#define PG8_BAR __builtin_amdgcn_s_barrier()
#define PG8_SCHED __builtin_amdgcn_sched_barrier(0)
    Unit cur, nxt; int ui = 0;
    if (!S.next(0, cur)) return;
    f32x4 acc[2][2][4][2];
#pragma unroll
    for (int a = 0; a < 2; ++a)
#pragma unroll
        for (int b = 0; b < 2; ++b)
#pragma unroll
            for (int m = 0; m < 4; ++m)
#pragma unroll
                for (int n = 0; n < 2; ++n) acc[a][b][m][n] = (f32x4){0.f, 0.f, 0.f, 0.f};
    bf16x8 At[4][2], B0[2][2], B1[2][2];
    const char* cA = cur.A; const char* cB = cur.B;
    if constexpr (SP2) {
        PG8_STAGE(PG8_SB(0, 0), cB, voffB); PG8_STAGE(PG8_SB(0, 1), cB + hsB, voffB); PG8_STAGE(PG8_SA(0, 0), cA, voffA); PG8_STAGE(PG8_SA(0, 1), cA + hsA, voffA);
        if (wr == 1) PG8_BAR;
        PG8_WAIT_V(2); PG8_BAR;
        PG8_STAGE(PG8_SB(1, 0), cB + kstep, voffB); PG8_STAGE(PG8_SA(1, 0), cA + kstep, voffA); PG8_STAGE(PG8_SB(1, 1), cB + hsB + kstep, voffB);
        PG8_WAIT_V(6); PG8_BAR;
    } else {
        PG8_STAGE(PG8_SB(0, 0), cB, voffB); PG8_STAGE(PG8_SA(0, 0), cA, voffA); PG8_STAGE(PG8_SB(0, 1), cB + hsB, voffB); PG8_STAGE(PG8_SA(0, 1), cA + hsA, voffA);
        if (wr == 1) PG8_BAR;
        PG8_WAIT_V(4); PG8_BAR;
        PG8_STAGE(PG8_SB(1, 0), cB + kstep, voffB); PG8_STAGE(PG8_SA(1, 0), cA + kstep, voffA); PG8_STAGE(PG8_SB(1, 1), cB + hsB + kstep, voffB);
        PG8_WAIT_V(6); PG8_BAR;
    }
    for (;;) {
        const bool has_next = S.next(ui + 1, nxt);
        const char* nA = has_next ? nxt.A : cA; const char* nB = has_next ? nxt.B : cB;
        for (int t = 0; t < nt; t += 2) {
            const bool last = (t == nt - 2);
            const char* a1 = cA + (size_t)(t + 1) * kstep;
            const char* a2 = last ? nA : cA + (size_t)(t + 2) * kstep; const char* b2 = last ? nB : cB + (size_t)(t + 2) * kstep;
            const char* a3 = a2 + kstep; const char* b3 = b2 + kstep;
            if constexpr (SP2) {
            PG8_LDB(B0, 0, 0); PG8_LDB(B1, 0, 1); PG8_SCHED; PG8_LDA(At, 0, 0); PG8_STAGE(PG8_SA(1, 1), a1 + hsA, voffA);
            PG8_WAIT_V(8); PG8_WAIT_L(0); PG8_BAR; PG8_MMA(0, 0, At, B0); PG8_MMA(0, 1, At, B1); PG8_BAR; PG8_SCHED;
            PG8_LDA(At, 0, 1); PG8_STAGE(PG8_SB(0, 0), b2, voffB); PG8_STAGE(PG8_SB(0, 1), b2 + hsB, voffB); PG8_STAGE(PG8_SA(0, 0), a2, voffA);
            PG8_WAIT_V(8); PG8_WAIT_L(0); PG8_BAR; PG8_MMA(1, 0, At, B0); PG8_MMA(1, 1, At, B1); PG8_BAR; PG8_SCHED;
            PG8_LDB(B0, 1, 0); PG8_LDB(B1, 1, 1); PG8_SCHED; PG8_LDA(At, 1, 0); PG8_STAGE(PG8_SA(0, 1), a2 + hsA, voffA);
            PG8_WAIT_V(8); PG8_WAIT_L(0); PG8_BAR; PG8_MMA(0, 0, At, B0); PG8_MMA(0, 1, At, B1); PG8_BAR; PG8_SCHED;
            PG8_LDA(At, 1, 1); PG8_STAGE(PG8_SB(1, 0), b3, voffB); PG8_STAGE(PG8_SB(1, 1), b3 + hsB, voffB); PG8_STAGE(PG8_SA(1, 0), a3, voffA);
            PG8_WAIT_V(8); PG8_WAIT_L(0); PG8_BAR; PG8_MMA(1, 0, At, B0); PG8_MMA(1, 1, At, B1); PG8_BAR; PG8_SCHED;
            } else {
            PG8_LDB(B0, 0, 0); PG8_SCHED; PG8_LDA(At, 0, 0); PG8_STAGE(PG8_SA(1, 1), a1 + hsA, voffA);
            PG8_WAIT_L(8); PG8_BAR; PG8_WAIT_L(0); PG8_MMA(0, 0, At, B0); PG8_BAR; PG8_SCHED;
            PG8_LDB(B1, 0, 1); PG8_STAGE(PG8_SB(0, 0), b2, voffB);
            PG8_BAR; PG8_WAIT_L(0); PG8_MMA(0, 1, At, B1); PG8_BAR;
            PG8_LDA(At, 0, 1); PG8_STAGE(PG8_SA(0, 0), a2, voffA);
            PG8_BAR; PG8_WAIT_L(0); PG8_MMA(1, 0, At, B0); PG8_BAR; PG8_SCHED;
            PG8_STAGE(PG8_SB(0, 1), b2 + hsB, voffB);
            PG8_WAIT_V(6); PG8_BAR; PG8_MMA(1, 1, At, B1); PG8_BAR;
            PG8_LDB(B0, 1, 0); PG8_SCHED; PG8_LDA(At, 1, 0); PG8_STAGE(PG8_SA(0, 1), a2 + hsA, voffA);
            PG8_WAIT_L(8); PG8_BAR; PG8_WAIT_L(0); PG8_MMA(0, 0, At, B0); PG8_BAR; PG8_SCHED;
            PG8_LDB(B1, 1, 1); PG8_STAGE(PG8_SB(1, 0), b3, voffB);
            PG8_BAR; PG8_WAIT_L(0); PG8_MMA(0, 1, At, B1); PG8_BAR;
            PG8_LDA(At, 1, 1); PG8_STAGE(PG8_SA(1, 0), a3, voffA);
            PG8_BAR; PG8_WAIT_L(0); PG8_MMA(1, 0, At, B0); PG8_BAR; PG8_SCHED;
            PG8_STAGE(PG8_SB(1, 1), b3 + hsB, voffB);
            PG8_WAIT_V(6); PG8_BAR; PG8_MMA(1, 1, At, B1); PG8_BAR;
            }
        }
        if constexpr (ALIGN_EPI) { if (wr == 0) PG8_BAR; }
        E(acc, cur, wr, wc, fr, fq);
        if (!has_next) break;
        if (!E.keep(cur)) {
#pragma unroll
            for (int a = 0; a < 2; ++a)
#pragma unroll
                for (int b = 0; b < 2; ++b)
#pragma unroll
                    for (int m = 0; m < 4; ++m)
#pragma unroll
                        for (int n = 0; n < 2; ++n) acc[a][b][m][n] = (f32x4){0.f, 0.f, 0.f, 0.f};
        }
        cur = nxt; cA = nA; cB = nB; ++ui;
        if constexpr (ALIGN_EPI) { if (wr == 1) PG8_BAR; }
    }
    PG8_WAIT_V(0);
    if constexpr (!ALIGN_EPI) { if (wr == 0) PG8_BAR; }
    PG8_BAR;
#undef PG8_SA
#undef PG8_SB
#undef PG8_STAGE
#undef PG8_LDA
#undef PG8_LDB
#undef PG8_MMA
#undef PG8_WAIT_V
#undef PG8_WAIT_L
#undef PG8_BAR
#undef PG8_SCHED
}
}

typedef f32x4 AccT[2][2][4][2];

struct EpiIn {
    u16* out[7]; const float* LB;
    __device__ __forceinline__ bool keep(const pg8::Unit&) const { return false; }
    template <int ACT> __device__ __forceinline__ void run(AccT& acc, const pg8::Unit& u, int wr, int wc, int fr, int fq, u16* O, const float* lbp) const {
        const int row0 = u.pm * 256 + wr * 64 + fr, colb = (u.pn & 3) * 256 + wc * 32 + 8 * fq;
#pragma unroll
        for (int bj = 0; bj < 2; ++bj) {
            const int col = colb + bj * 128;
            float lbv[8];
            if (ACT == 2) { const f32x4 l0 = *(const f32x4*)(lbp + col), l1 = *(const f32x4*)(lbp + col + 4);
                lbv[0] = l0[0]; lbv[1] = l0[1]; lbv[2] = l0[2]; lbv[3] = l0[3]; lbv[4] = l1[0]; lbv[5] = l1[1]; lbv[6] = l1[2]; lbv[7] = l1[3]; }
#pragma unroll
            for (int ai = 0; ai < 2; ++ai)
#pragma unroll
                for (int m = 0; m < 4; ++m) {
                    const int row = row0 + ai * 128 + m * 16;
                    float v[8];
#pragma unroll
                    for (int e = 0; e < 4; ++e) { v[e] = acc[ai][bj][m][0][e]; v[4 + e] = acc[ai][bj][m][1][e]; }
                    u32x4 w;
                    if (ACT == 2) {
                        unsigned ww[4];
#pragma unroll
                        for (int e = 0; e < 4; ++e) {
                            const float f0 = lbv[2 * e] + (1.f - lbv[2 * e]) * sigmoid_f(v[2 * e]);
                            const float f1 = lbv[2 * e + 1] + (1.f - lbv[2 * e + 1]) * sigmoid_f(v[2 * e + 1]);
                            h16x2 hp; hp.x = (_Float16)__logf(f0); hp.y = (_Float16)__logf(f1);
                            ww[e] = __builtin_bit_cast(unsigned, hp);
                        }
                        w.x = ww[0]; w.y = ww[1]; w.z = ww[2]; w.w = ww[3];
                    } else {
#pragma unroll
                        for (int e = 0; e < 8; ++e) { if (ACT == 1) v[e] = silu_f(v[e]); if (ACT == 3) v[e] = sigmoid_f(v[e]); }
                        w.x = cvt_pk_bf16(v[0], v[1]); w.y = cvt_pk_bf16(v[2], v[3]); w.z = cvt_pk_bf16(v[4], v[5]); w.w = cvt_pk_bf16(v[6], v[7]);
                    }
                    *(u32x4*)(O + (size_t)row * D + col) = w;
                }
        }
    }
    __device__ __forceinline__ void operator()(AccT& acc, const pg8::Unit& u, int wr, int wc, int fr, int fq) const {
        const int seg = u.pn >> 2; u16* O = seg == 0 ? out[0] : seg == 1 ? out[1] : seg == 2 ? out[2] : seg == 3 ? out[3] : seg == 4 ? out[4] : seg == 5 ? out[5] : out[6];
        if (seg == 0 || seg == 4) run<1>(acc, u, wr, wc, fr, fq, O, LB);
        else if (seg == 1 || seg == 2) run<2>(acc, u, wr, wc, fr, fq, O, LB + (seg - 1) * 1024);
        else if (seg == 3) run<0>(acc, u, wr, wc, fr, fq, O, LB);
        else run<3>(acc, u, wr, wc, fr, fq, O, LB);
    }
};
struct EpiBf {
    u16* O; int ld;
    __device__ __forceinline__ bool keep(const pg8::Unit&) const { return false; }
    __device__ __forceinline__ void operator()(AccT& acc, const pg8::Unit& u, int wr, int wc, int fr, int fq) const {
        const int row0 = u.pm * 256 + wr * 64 + fr, colb = u.pn * 256 + wc * 32 + 8 * fq;
#pragma unroll
        for (int ai = 0; ai < 2; ++ai)
#pragma unroll
            for (int m = 0; m < 4; ++m)
#pragma unroll
                for (int bj = 0; bj < 2; ++bj) {
                    const f32x4 v0 = acc[ai][bj][m][0], v1 = acc[ai][bj][m][1];
                    u32x4 w; w.x = cvt_pk_bf16(v0[0], v0[1]); w.y = cvt_pk_bf16(v0[2], v0[3]); w.z = cvt_pk_bf16(v1[0], v1[1]); w.w = cvt_pk_bf16(v1[2], v1[3]);
                    *(u32x4*)(O + (size_t)(row0 + ai * 128 + m * 16) * ld + colb + bj * 128) = w;
                }
    }
};
struct EpiMerge {
    const u16* GA; const u16* GB; u16* T1;
    __device__ __forceinline__ bool keep(const pg8::Unit& u) const { return u.aux == 0; }
    __device__ __forceinline__ void operator()(AccT& acc, const pg8::Unit& u, int wr, int wc, int fr, int fq) const {
        const int row0 = u.pm * 256 + wr * 64 + fr, colb = u.pn * 256 + wc * 32 + 8 * fq;
#pragma unroll
        for (int ai = 0; ai < 2; ++ai)
#pragma unroll
            for (int m = 0; m < 4; ++m)
#pragma unroll
                for (int bj = 0; bj < 2; ++bj) {
                    const size_t idx = (size_t)(row0 + ai * 128 + m * 16) * D + colb + bj * 128;
                    const u32x4 gb = *(const u32x4*)(GB + idx);
                    float b[8] = {bflo(gb.x), bfhi(gb.x), bflo(gb.y), bfhi(gb.y), bflo(gb.z), bfhi(gb.z), bflo(gb.w), bfhi(gb.w)};
                    if (u.aux == 0) {
                        const u32x4 ga = *(const u32x4*)(GA + idx);
                        float a[8] = {bflo(ga.x), bfhi(ga.x), bflo(ga.y), bfhi(ga.y), bflo(ga.z), bfhi(ga.z), bflo(ga.w), bfhi(ga.w)};
#pragma unroll
                        for (int e = 0; e < 4; ++e) { acc[ai][bj][m][0][e] *= a[e] * __builtin_amdgcn_rcpf(fmaxf(b[e], 1e-30f)); acc[ai][bj][m][1][e] *= a[4 + e] * __builtin_amdgcn_rcpf(fmaxf(b[4 + e], 1e-30f)); }
                    } else {
                        const f32x4 v0 = acc[ai][bj][m][0], v1 = acc[ai][bj][m][1];
                        u32x4 w; w.x = cvt_pk_bf16(v0[0] * b[0], v0[1] * b[1]); w.y = cvt_pk_bf16(v0[2] * b[2], v0[3] * b[3]);
                        w.z = cvt_pk_bf16(v1[0] * b[4], v1[1] * b[5]); w.w = cvt_pk_bf16(v1[2] * b[6], v1[3] * b[7]);
                        *(u32x4*)(T1 + idx) = w;
                    }
                }
    }
};
template <bool RBF>
struct EpiRes {
    const void* R0; const void* R1; const float* gate; u16* O;
    __device__ __forceinline__ bool keep(const pg8::Unit&) const { return false; }
    __device__ __forceinline__ void operator()(AccT& acc, const pg8::Unit& u, int wr, int wc, int fr, int fq) const {
        const int row0 = u.pm * 256 + wr * 64 + fr, colb = u.pn * 256 + wc * 32 + 8 * fq;
        const float* gp = gate + (size_t)cid_of(u.pm * 256) * NMOD;
#pragma unroll
        for (int bj = 0; bj < 2; ++bj) {
            const int col = colb + bj * 128;
            const f32x4 g0 = *(const f32x4*)(gp + col), g1 = *(const f32x4*)(gp + col + 4);
#pragma unroll
            for (int ai = 0; ai < 2; ++ai)
#pragma unroll
                for (int m = 0; m < 4; ++m) {
                    const int row = row0 + ai * 128 + m * 16;
                    float x[8];
                    if (RBF) {
                        const u32x4 xr = *(const u32x4*)((const u16*)R0 + (size_t)row * D + col);
                        x[0] = bflo(xr.x); x[1] = bfhi(xr.x); x[2] = bflo(xr.y); x[3] = bfhi(xr.y); x[4] = bflo(xr.z); x[5] = bfhi(xr.z); x[6] = bflo(xr.w); x[7] = bfhi(xr.w);
                    } else {
                        const float* rp = (row < 8192 ? (const float*)R0 + (size_t)row * D : (const float*)R1 + (size_t)(row - 8192) * D) + col;
                        const f32x4 x0 = *(const f32x4*)rp, x1 = *(const f32x4*)(rp + 4);
                        x[0] = x0[0]; x[1] = x0[1]; x[2] = x0[2]; x[3] = x0[3]; x[4] = x1[0]; x[5] = x1[1]; x[6] = x1[2]; x[7] = x1[3];
                    }
                    float o[8];
#pragma unroll
                    for (int e = 0; e < 4; ++e) { o[e] = ALPHA * x[e] + g0[e] * acc[ai][bj][m][0][e]; o[4 + e] = ALPHA * x[4 + e] + g1[e] * acc[ai][bj][m][1][e]; }
                    u32x4 w; w.x = cvt_pk_bf16(o[0], o[1]); w.y = cvt_pk_bf16(o[2], o[3]); w.z = cvt_pk_bf16(o[4], o[5]); w.w = cvt_pk_bf16(o[6], o[7]);
                    *(u32x4*)(O + (size_t)row * D + col) = w;
                }
        }
    }
};
struct EpiGlu {
    u16* FF;
    __device__ __forceinline__ bool keep(const pg8::Unit&) const { return false; }
    __device__ __forceinline__ void operator()(AccT& acc, const pg8::Unit& u, int wr, int wc, int fr, int fq) const {
        const int row0 = u.pm * 256 + wr * 64 + fr, col = u.pn * 128 + wc * 32 + 8 * fq;
#pragma unroll
        for (int ai = 0; ai < 2; ++ai)
#pragma unroll
            for (int m = 0; m < 4; ++m) {
                float v[8];
#pragma unroll
                for (int e = 0; e < 4; ++e) { v[e] = silu_f(acc[ai][0][m][0][e]) * acc[ai][1][m][0][e]; v[4 + e] = silu_f(acc[ai][0][m][1][e]) * acc[ai][1][m][1][e]; }
                u32x4 w; w.x = cvt_pk_bf16(v[0], v[1]); w.y = cvt_pk_bf16(v[2], v[3]); w.z = cvt_pk_bf16(v[4], v[5]); w.w = cvt_pk_bf16(v[6], v[7]);
                *(u32x4*)(FF + (size_t)(row0 + ai * 128 + m * 16) * DFF + col) = w;
            }
    }
};

__device__ __forceinline__ void convert_tile4(LAS unsigned char* lds, const float* W, u16* WT, int K, int N, int su) {
    LAS float* tl = (LAS float*)lds;
    const int tiles_n = N >> 8, tk = su / tiles_n, tn = su - tk * tiles_n, k0 = tk * 64, n0 = tn * 256, tid = threadIdx.x;
    {
        const int kr = tid >> 6, nc = (tid & 63) * 4;
        f32x4 v[8];
#pragma unroll
        for (int it = 0; it < 8; ++it) v[it] = *(const f32x4*)(W + (size_t)(k0 + kr + 8 * it) * N + n0 + nc);
#pragma unroll
        for (int it = 0; it < 8; ++it) { LAS float* d = tl + (kr + 8 * it) * 257 + nc; d[0] = v[it][0]; d[1] = v[it][1]; d[2] = v[it][2]; d[3] = v[it][3]; }
    }
    __syncthreads();
    {
        const int nr = tid >> 1, kc = (tid & 1) * 32;
#pragma unroll
        for (int q = 0; q < 4; ++q) {
            float v[8];
#pragma unroll
            for (int e = 0; e < 8; ++e) v[e] = tl[(kc + 8 * q + e) * 257 + nr];
            u32x4 w; w.x = cvt_pk_bf16(v[0], v[1]); w.y = cvt_pk_bf16(v[2], v[3]); w.z = cvt_pk_bf16(v[4], v[5]); w.w = cvt_pk_bf16(v[6], v[7]);
            *(u32x4*)(WT + (size_t)(n0 + nr) * K + k0 + kc + 8 * q) = w;
        }
    }
    __syncthreads();
}

__device__ __forceinline__ void phase_prep(LAS unsigned char* lds, const Ctx& C) {
    const int tid = threadIdx.x;
    u16* WIN = (u16*)(C.ws + WS_WIN); u16* WPA = (u16*)(C.ws + WS_WPA); u16* WPB = (u16*)(C.ws + WS_WPB); u16* WOUT = (u16*)(C.ws + WS_WOUT);
    float* MOD = (float*)(C.ws + WS_MOD); float* LB = (float*)(C.ws + WS_LB);
    constexpr int N_CV = 640 + 64 * 3, N_MODU = 192, N_H3 = 272, N_ALL = N_CV + N_MODU + N_H3 + 1;
    for (int u = blockIdx.x; u < N_ALL; u += gridDim.x) {
        if (u < N_CV) {
            if (u < 640) convert_tile4(lds, C.in[7], WIN, 1024, NIN, u);
            else if (u < 704) convert_tile4(lds, C.in[21], WPA, 1024, 1024, u - 640);
            else if (u < 768) convert_tile4(lds, C.in[22], WPB, 1024, 1024, u - 704);
            else convert_tile4(lds, C.in[23], WOUT, 1024, 1024, u - 768);
        } else if (u < N_CV + N_MODU) {
            const int mu = u - N_CV, n0 = mu * 32, col = tid & 31, ks = tid >> 5;
            const float* cctx = C.in[4]; const float* cc = C.in[3]; const float* aw = C.in[5];
            LAS float* sc = (LAS float*)lds;
            LAS float* red = (LAS float*)(lds + 12288);
            for (int i = tid; i < 3072; i += 512) sc[i] = silu_f(i < 1024 ? cctx[i] : cc[i - 1024]);
            __syncthreads();
            float a0 = 0.f, a1 = 0.f, a2 = 0.f;
#pragma unroll
            for (int kb = 0; kb < 64; kb += 16) {
                float w[16];
#pragma unroll
                for (int kk = 0; kk < 16; ++kk) w[kk] = aw[(size_t)(ks * 64 + kb + kk) * NMOD + n0 + col];
#pragma unroll
                for (int kk = 0; kk < 16; ++kk) { const int k = ks * 64 + kb + kk; a0 += sc[k] * w[kk]; a1 += sc[1024 + k] * w[kk]; a2 += sc[2048 + k] * w[kk]; }
            }
            red[(0 * 16 + ks) * 32 + col] = a0; red[(1 * 16 + ks) * 32 + col] = a1; red[(2 * 16 + ks) * 32 + col] = a2;
            __syncthreads();
            if (tid < 96) { const int ci = tid >> 5, c2 = tid & 31; float s2 = C.in[6][n0 + c2];
#pragma unroll
                for (int k = 0; k < 16; ++k) s2 += red[(ci * 16 + k) * 32 + c2];
                MOD[ci * NMOD + n0 + c2] = s2; }
            __syncthreads();
        } else if (u < N_CV + N_MODU + N_H3) {
            const int hu = u - N_CV - N_MODU, pl = tid >> 6, j = tid & 63;
            LAS float* zs = (LAS float*)lds;
            LAS float* h1 = (LAS float*)(lds + 4096);
            LAS float* h2 = (LAS float*)(lds + 8192);
            u16* Hhi[2]; u16* Hlo[2];
#pragma unroll
            for (int pp = 0; pp < 2; ++pp) {
                const int pos = hu * 16 + pl + 8 * pp;
                const int L = pos < 256 ? 256 : 4096, t = pos < 256 ? pos : pos - 256;
                Hhi[pp] = pos < 256 ? (u16*)(C.ws + WS_H3P) + (size_t)t * 64 : (u16*)(C.ws + WS_H3S) + (size_t)t * 64;
                Hlo[pp] = Hhi[pp] + (pos < 256 ? 256 * 64 : 4096 * 64);
                if (j < 33) {
                    float z;
                    if (j == 0) z = (float)t / (float)(L - 1);
                    else {
                        const int bnd = (j - 1) & 15;
                        const float band = 1e-4f + (float)bnd * ((15.0f - 1e-4f) / 15.0f);
                        const float wpos = (float)(6.283185307179586 / (double)L) * (float)t;
                        const float ang = band * wpos;
                        z = (j <= 16) ? my_cos(ang) : -my_sin(ang);
                    }
                    zs[(pl + 8 * pp) * 40 + j] = z;
                }
            }
            __syncthreads();
            const float* fq = C.in[18];
            { float s0 = C.in[13][j], s1 = s0; const float* w1 = C.in[12];
#pragma unroll 11
              for (int i = 0; i < 33; ++i) { const float w = w1[i * 64 + j]; s0 += zs[pl * 40 + i] * w; s1 += zs[(pl + 8) * 40 + i] * w; }
              h1[pl * 64 + j] = my_sin(fq[j] * s0); h1[(pl + 8) * 64 + j] = my_sin(fq[j] * s1); }
            __syncthreads();
            { float s0 = C.in[15][j], s1 = s0; const float* w2 = C.in[14];
#pragma unroll 32
              for (int i = 0; i < 64; ++i) { const float w = w2[i * 64 + j]; s0 += h1[pl * 64 + i] * w; s1 += h1[(pl + 8) * 64 + i] * w; }
              h2[pl * 64 + j] = my_sin(fq[64 + j] * s0); h2[(pl + 8) * 64 + j] = my_sin(fq[64 + j] * s1); }
            __syncthreads();
            { float s0 = C.in[17][j], s1 = s0; const float* w3 = C.in[16];
#pragma unroll 32
              for (int i = 0; i < 64; ++i) { const float w = w3[i * 64 + j]; s0 += h2[pl * 64 + i] * w; s1 += h2[(pl + 8) * 64 + i] * w; }
              const float hv0 = my_sin(fq[128 + j] * s0), hv1 = my_sin(fq[128 + j] * s1);
              const u16 hb0 = f2bf(hv0), hb1 = f2bf(hv1);
              Hhi[0][j] = hb0; Hlo[0][j] = f2bf(hv0 - bf2f(hb0)); Hhi[1][j] = hb1; Hlo[1][j] = f2bf(hv1 - bf2f(hb1)); }
            __syncthreads();
        } else {
            const float* lg = C.in[8];
            for (int i = tid; i < 2048; i += 512) LB[i] = 1.f / (1.f + expf(lg[2048 + i] - lg[i]));
        }
    }
}

__device__ __forceinline__ void phase_modulate(const Ctx& C) {
    const int tid = threadIdx.x, c8 = (tid & 127) * 8, r4 = tid >> 7;
    const float* MOD = (const float*)(C.ws + WS_MOD); u16* HB = (u16*)(C.ws + WS_HB);
    for (int ch = blockIdx.x; ch < T / 64; ch += gridDim.x) {
        const int tok0 = ch * 64; const float* mp = MOD + (size_t)cid_of(tok0) * NMOD;
        float sh[8], sc[8];
#pragma unroll
        for (int e = 0; e < 8; ++e) { sh[e] = mp[c8 + e]; sc[e] = 1.f + mp[1024 + c8 + e]; }
#pragma unroll
        for (int hb = 0; hb < 2; ++hb) {
            f32x4 a[8], b[8];
#pragma unroll
            for (int it = 0; it < 8; ++it) { const float* xp = C.xrow(tok0 + r4 + 4 * (8 * hb + it)) + c8; a[it] = *(const f32x4*)xp; b[it] = *(const f32x4*)(xp + 4); }
#pragma unroll
            for (int it = 0; it < 8; ++it) {
                const int tok = tok0 + r4 + 4 * (8 * hb + it);
                u32x4 w; w.x = cvt_pk_bf16(a[it][0] * sc[0] + sh[0], a[it][1] * sc[1] + sh[1]); w.y = cvt_pk_bf16(a[it][2] * sc[2] + sh[2], a[it][3] * sc[3] + sh[3]);
                w.z = cvt_pk_bf16(b[it][0] * sc[4] + sh[4], b[it][1] * sc[5] + sh[5]); w.w = cvt_pk_bf16(b[it][2] * sc[6] + sh[6], b[it][3] * sc[7] + sh[7]);
                *(u32x4*)(HB + (size_t)tok * D + c8) = w;
            }
        }
    }
}

__device__ __forceinline__ float wave_sum(float v) {
#pragma unroll
    for (int o = 32; o >= 1; o >>= 1) v += __shfl_xor(v, o, 64);
    return v;
}
template <bool WITH_H>
__device__ __forceinline__ void phase_ln(const Ctx& C, const u16* U, float* Y, u16* Y16, const float* gam, const float* bet, u16* H, int scale_idx, int shift_idx) {
    const int lane = threadIdx.x & 63, wv = threadIdx.x >> 6;
    const float* MOD = (const float*)(C.ws + WS_MOD);
    for (int row0 = (blockIdx.x * 8 + wv) * 4; row0 < T; row0 += gridDim.x * 32) {
        u32x4 raw[4][2];
#pragma unroll
        for (int rr = 0; rr < 4; ++rr)
#pragma unroll
            for (int i = 0; i < 2; ++i) raw[rr][i] = *(const u32x4*)(U + (size_t)(row0 + rr) * D + 8 * lane + 512 * i);
        const float* mp = MOD + (size_t)cid_of(row0) * NMOD;
#pragma unroll
        for (int rr = 0; rr < 4; ++rr) {
            const int row = row0 + rr;
            float v[2][8];
#pragma unroll
            for (int i = 0; i < 2; ++i) { const u32x4 r = raw[rr][i];
                v[i][0] = bflo(r.x); v[i][1] = bfhi(r.x); v[i][2] = bflo(r.y); v[i][3] = bfhi(r.y); v[i][4] = bflo(r.z); v[i][5] = bfhi(r.z); v[i][6] = bflo(r.w); v[i][7] = bfhi(r.w); }
            float s = 0.f;
#pragma unroll
            for (int i = 0; i < 2; ++i)
#pragma unroll
                for (int e = 0; e < 8; ++e) s += v[i][e];
            const float mu = wave_sum(s) * (1.f / 1024.f);
            float q = 0.f;
#pragma unroll
            for (int i = 0; i < 2; ++i)
#pragma unroll
                for (int e = 0; e < 8; ++e) { const float d = v[i][e] - mu; q += d * d; }
            const float rstd = rsqrtf(wave_sum(q) * (1.f / 1024.f) + 1e-5f);
#pragma unroll
            for (int i = 0; i < 2; ++i) {
                const int col = 8 * lane + 512 * i;
                const f32x4 g0 = *(const f32x4*)(gam + col), g1 = *(const f32x4*)(gam + col + 4), b0 = *(const f32x4*)(bet + col), b1 = *(const f32x4*)(bet + col + 4);
                float y[8];
#pragma unroll
                for (int e = 0; e < 4; ++e) { y[e] = (v[i][e] - mu) * rstd * g0[e] + b0[e]; y[4 + e] = (v[i][4 + e] - mu) * rstd * g1[e] + b1[e]; }
                if (WITH_H) {
                    u32x4 w; w.x = cvt_pk_bf16(y[0], y[1]); w.y = cvt_pk_bf16(y[2], y[3]); w.z = cvt_pk_bf16(y[4], y[5]); w.w = cvt_pk_bf16(y[6], y[7]);
                    *(u32x4*)(Y16 + (size_t)row * D + col) = w;
                    const f32x4 sc0 = *(const f32x4*)(mp + scale_idx * 1024 + col), sc1 = *(const f32x4*)(mp + scale_idx * 1024 + col + 4);
                    const f32x4 sh0 = *(const f32x4*)(mp + shift_idx * 1024 + col), sh1 = *(const f32x4*)(mp + shift_idx * 1024 + col + 4);
                    float hv[8];
#pragma unroll
                    for (int e = 0; e < 4; ++e) { hv[e] = y[e] * (1.f + sc0[e]) + sh0[e]; hv[4 + e] = y[4 + e] * (1.f + sc1[e]) + sh1[e]; }
                    w.x = cvt_pk_bf16(hv[0], hv[1]); w.y = cvt_pk_bf16(hv[2], hv[3]); w.z = cvt_pk_bf16(hv[4], hv[5]); w.w = cvt_pk_bf16(hv[6], hv[7]);
                    *(u32x4*)(H + (size_t)row * D + col) = w;
                } else {
                    float* yp = Y + (size_t)row * D + col;
                    *(f32x4*)yp = (f32x4){y[0], y[1], y[2], y[3]}; *(f32x4*)(yp + 4) = (f32x4){y[4], y[5], y[6], y[7]};
                }
            }
        }
    }
}

__device__ __forceinline__ void short_conv8(const u16* row, int p0, int RL, float w0, float w1, float w2, float bias, float* out) {
    const u32x4 raw = *(const u32x4*)(row + p0);
    float u[10];
    u[1] = bflo(raw.x); u[2] = bfhi(raw.x); u[3] = bflo(raw.y); u[4] = bfhi(raw.y); u[5] = bflo(raw.z); u[6] = bfhi(raw.z); u[7] = bflo(raw.w); u[8] = bfhi(raw.w);
    u[0] = (p0 & (RL - 1)) != 0 ? bf2f(row[p0 - 1]) : 0.f;
    u[9] = ((p0 + 8) & (RL - 1)) != 0 ? bf2f(row[p0 + 8]) : 0.f;
#pragma unroll
    for (int e = 0; e < 8; ++e) out[e] = w0 * u[e] + w1 * u[e + 1] + w2 * u[e + 2] + bias;
}
__device__ __forceinline__ int zswz(int p8) { return 80 * (p8 >> 2) + 16 * (p8 & 3); }

struct ToepRaw { unsigned w0, w1, w2, w3, w4; };
__device__ __forceinline__ ToepRaw toep_load(const LAS unsigned* FRw, int mb) {
    const int dw = mb >> 1; ToepRaw r; r.w0 = FRw[dw]; r.w1 = FRw[dw + 1]; r.w2 = FRw[dw + 2]; r.w3 = FRw[dw + 3]; r.w4 = FRw[dw + 4]; return r;
}
__device__ __forceinline__ bf16x8 toep_align(const ToepRaw& r, unsigned sh) {
    u32x4 o; o.x = __builtin_amdgcn_alignbyte(r.w1, r.w0, sh); o.y = __builtin_amdgcn_alignbyte(r.w2, r.w1, sh); o.z = __builtin_amdgcn_alignbyte(r.w3, r.w2, sh); o.w = __builtin_amdgcn_alignbyte(r.w4, r.w3, sh);
    return __builtin_bit_cast(bf16x8, o);
}
__device__ __forceinline__ int zaddr(int b, int piece) { return 64 * b + 16 * (piece ^ ((b >> 2) & 3)); }
template <int M>
__device__ __forceinline__ void toep_run(f32x16 (&acc)[4], const LAS unsigned* FRw, int mb0, const LAS unsigned char* Zc, int b00, int bstep, int g, int k0, int k1) {
    const unsigned sh = (unsigned)(mb0 & 1) * 2u;
    ToepRaw r0 = toep_load(FRw, mb0 - 32 * k0), r1 = toep_load(FRw, mb0 - 32 * k0 + 16);
    bf16x8 bc[4][2];
#pragma unroll
    for (int j = 0; j < 4; ++j) if ((M >> j) & 1) { const int b = b00 + j * bstep - k0; bc[j][0] = *(const LAS bf16x8*)(Zc + zaddr(b, g)); bc[j][1] = *(const LAS bf16x8*)(Zc + zaddr(b, 2 + g)); }
#pragma unroll 1
    for (int k = k0; k <= k1; ++k) {
        const bf16x8 a0 = toep_align(r0, sh), a1 = toep_align(r1, sh);
        const int kn = k < k1 ? k + 1 : k;
        r0 = toep_load(FRw, mb0 - 32 * kn); r1 = toep_load(FRw, mb0 - 32 * kn + 16);
        bf16x8 bn[4][2];
#pragma unroll
        for (int j = 0; j < 4; ++j) if ((M >> j) & 1) { const int b = b00 + j * bstep - kn; bn[j][0] = *(const LAS bf16x8*)(Zc + zaddr(b, g)); bn[j][1] = *(const LAS bf16x8*)(Zc + zaddr(b, 2 + g)); }
#pragma unroll
        for (int j = 0; j < 4; ++j) if ((M >> j) & 1) acc[j] = mfma32(a0, bc[j][0], acc[j]);
#pragma unroll
        for (int j = 0; j < 4; ++j) if ((M >> j) & 1) acc[j] = mfma32(a1, bc[j][1], acc[j]);
#pragma unroll
        for (int j = 0; j < 4; ++j) if ((M >> j) & 1) { bc[j][0] = bn[j][0]; bc[j][1] = bn[j][1]; }
    }
}

__device__ __forceinline__ void conv_unit(LAS unsigned char* lds, const Ctx& C, int smp, int cgi) {
    const int tid = threadIdx.x, lane = tid & 63, wv = tid >> 6;
    const int L = smp ? 4096 : 256, nb = L >> 5, lnb = smp ? 7 : 3, RL = smp ? 64 : 256, utok0 = smp ? 8192 : 0, d0 = 4 * cgi;
    const int P = smp ? 31 : 7, nblk = smp ? 349 : 487, ZCH = nblk * 64, FRS = 4 * L;
    const u16* H3hi = smp ? (const u16*)(C.ws + WS_H3S) : (const u16*)(C.ws + WS_H3P);
    const u16* H3lo = H3hi + (size_t)L * 64;
    const u16* HYT = (const u16*)(C.ws + WS_R60);
    u16* OB = (u16*)C.out;
    LAS unsigned char* FRb = lds;
    LAS unsigned char* Zb = lds + 4 * FRS;
#define ZPOS(n) (P + ((n) >> lnb) * (nb + P) + ((n) & (nb - 1)))
    {
        const int n = lane & 31, hh = lane >> 5, o = n & 7, c = o & 3;
        const int gcol = (o >> 2) * 1024 + d0 + c;
        bf16x8 Bhi[4], Blo[4];
#pragma unroll
        for (int kk = 0; kk < 4; ++kk) {
            float wv8[8], wl8[8];
#pragma unroll
            for (int e = 0; e < 8; ++e) {
                const float w = (n < 8) ? C.in[19][(size_t)(16 * kk + 8 * hh + e) * 2048 + gcol] : 0.f;
                const float whi = bf2f(f2bf(w)); wv8[e] = whi; wl8[e] = w - whi;
            }
            Bhi[kk] = pack8(wv8[0], wv8[1], wv8[2], wv8[3], wv8[4], wv8[5], wv8[6], wv8[7]);
            Blo[kk] = pack8(wl8[0], wl8[1], wl8[2], wl8[3], wl8[4], wl8[5], wl8[6], wl8[7]);
        }
        const float mind = -3.0701134573253943f, maxd = -15.350567286626972f;
        const float escale = -1.4426950408889634f / (float)(L - 1);
        float delta4[4], skip4[4];
#pragma unroll
        for (int cc = 0; cc < 4; ++cc) { delta4[cc] = fabsf(mind + (maxd - mind) * ((float)(d0 + cc) / 1023.f)); skip4[cc] = C.in[20][d0 + cc]; }
        if (tid < 4) ((LAS u16*)(FRb + tid * FRS))[0] = 0;
        const int nrb = L >> 5;
        const int wvu = __builtin_amdgcn_readfirstlane(wv);
        LAS unsigned char* stg = Zb + wvu * 8192;
        const int goff0 = (lane >> 3) * 128 + 16 * ((lane & 7) ^ ((lane >> 3) & 7));
#define FILT_DMA(rbx) do { const unsigned char* gh_ = (const unsigned char*)H3hi + (size_t)(rbx) * 4096; const unsigned char* gl_ = (const unsigned char*)H3lo + (size_t)(rbx) * 4096; \
        _Pragma("unroll") for (int q = 0; q < 4; ++q) { \
            __builtin_amdgcn_global_load_lds((const unsigned*)(gh_ + goff0 + 1024 * q), (LAS unsigned*)(stg + 1024 * q), 16, 0, 0); \
            __builtin_amdgcn_global_load_lds((const unsigned*)(gl_ + goff0 + 1024 * q), (LAS unsigned*)(stg + 4096 + 1024 * q), 16, 0, 0); } } while (0)
        if (wvu < nrb) FILT_DMA(wvu);
        for (int rb = wvu; rb < nrb; rb += 8) {
            asm volatile("s_waitcnt vmcnt(0)" ::: "memory");
            bf16x8 xh[4], xl[4];
#pragma unroll
            for (int kk = 0; kk < 4; ++kk) { const int off = n * 128 + 16 * ((2 * kk + hh) ^ (n & 7));
                xh[kk] = *(const LAS bf16x8*)(stg + off); xl[kk] = *(const LAS bf16x8*)(stg + 4096 + off); }
            asm volatile("s_waitcnt lgkmcnt(0)" ::: "memory");
            if (rb + 8 < nrb) FILT_DMA(rb + 8);
            f32x16 acc;
#pragma unroll
            for (int e = 0; e < 16; ++e) acc[e] = 0.f;
#pragma unroll
            for (int kk = 0; kk < 4; ++kk) { acc = mfma32(Bhi[kk], xh[kk], acc); acc = mfma32(Bhi[kk], xl[kk], acc); acc = mfma32(Blo[kk], xh[kk], acc); }
            {
                const int tt = 32 * rb + n;
                const float tsc = (float)tt * escale;
#pragma unroll
                for (int cc = 0; cc < 4; ++cc) {
                    const float win = __builtin_amdgcn_exp2f(tsc * delta4[cc]) + 0.05f;
                    float val = acc[cc] * win;
                    LAS u16* frc = (LAS u16*)(FRb + cc * FRS);
                    if (hh == 0) { if (tt == 0) val += skip4[cc]; frc[L - tt] = f2bf(val); }
                    else if (tt > 0) frc[L + tt] = f2bf(val);
                }
            }
        }
    }
#undef FILT_DMA
    __syncthreads();
    {
        const int npp = P * ((smp ? 2 : 32) + 1) * 4;
        for (int i = tid; i < 4 * npp; i += 512) {
            const int chz = i / npp, pb = i - chz * npp, pbk = pb >> 2, g7 = pbk / P;
            *(LAS u32x4*)(Zb + chz * ZCH + zaddr((nb + P) * g7 + (pbk - g7 * P), pb & 3)) = (u32x4){0u, 0u, 0u, 0u};
        }
    }
    {
        const float* cw = C.in[10]; const float* cb = C.in[11];
#pragma unroll
        for (int it = 0; it < 8; ++it) {
            const int c = it >> 1, q = tid + 512 * (it & 1), p0 = 8 * q;
            const int c1 = 1024 + d0 + c, c2 = 2048 + d0 + c;
            float s1[8], s2[8];
            short_conv8(HYT + (size_t)c1 * T + utok0, p0, RL, cw[c1], cw[3072 + c1], cw[6144 + c1], cb[c1], s1);
            short_conv8(HYT + (size_t)c2 * T + utok0, p0, RL, cw[c2], cw[3072 + c2], cw[6144 + c2], cb[c2], s2);
            u32x4 w; w.x = cvt_pk_bf16(s1[0] * s2[0], s1[1] * s2[1]); w.y = cvt_pk_bf16(s1[2] * s2[2], s1[3] * s2[3]);
            w.z = cvt_pk_bf16(s1[4] * s2[4], s1[5] * s2[5]); w.w = cvt_pk_bf16(s1[6] * s2[6], s1[7] * s2[7]);
            *(LAS u32x4*)(Zb + c * ZCH + zaddr(ZPOS(q >> 2), q & 3)) = w;
        }
    }
    __syncthreads();
    const int ch = wv >> 1, sub = wv & 1, i = lane & 31, g = lane >> 5;
    const LAS unsigned* FRw = (const LAS unsigned*)(FRb + ch * FRS);
    const LAS unsigned char* Zc = Zb + ch * ZCH;
    f32x16 acc[4];
#pragma unroll
    for (int j = 0; j < 4; ++j)
#pragma unroll
        for (int e = 0; e < 16; ++e) acc[j][e] = 0.f;
    const int mb0 = L - i + 8 * g;
    const int b00 = ZPOS(32 * 4 * sub + i), bstep = smp ? 32 : 60;
    if (smp) {
        toep_run<1>(acc, FRw, mb0, Zc, b00, bstep, g, -127, -96);
        toep_run<3>(acc, FRw, mb0, Zc, b00, bstep, g, -95, -64);
        toep_run<7>(acc, FRw, mb0, Zc, b00, bstep, g, -63, -32);
        toep_run<15>(acc, FRw, mb0, Zc, b00, bstep, g, -31, 31);
        toep_run<14>(acc, FRw, mb0, Zc, b00, bstep, g, 32, 63);
        toep_run<12>(acc, FRw, mb0, Zc, b00, bstep, g, 64, 95);
        toep_run<8>(acc, FRw, mb0, Zc, b00, bstep, g, 96, 127);
    } else {
        toep_run<15>(acc, FRw, mb0, Zc, b00, bstep, g, -7, 7);
    }
    __syncthreads();
    {
        const float* cw = C.in[10]; const float* cb = C.in[11];
#pragma unroll
        for (int it = 0; it < 8; ++it) {
            const int c = it >> 1, q = tid + 512 * (it & 1), p0 = 8 * q, c0 = d0 + c;
            float s0[8];
            short_conv8(HYT + (size_t)c0 * T + utok0, p0, RL, cw[c0], cw[3072 + c0], cw[6144 + c0], cb[c0], s0);
            u32x4 w; w.x = cvt_pk_bf16(s0[0], s0[1]); w.y = cvt_pk_bf16(s0[2], s0[3]); w.z = cvt_pk_bf16(s0[4], s0[5]); w.w = cvt_pk_bf16(s0[6], s0[7]);
            *(LAS u32x4*)(Zb + c * ZCH + zaddr(ZPOS(q >> 2), q & 3)) = w;
        }
    }
    __syncthreads();
    {
        u16* orow = OB + (size_t)(d0 + ch) * T + utok0;
#pragma unroll
        for (int j = 0; j < 4; ++j) {
            const int n = 32 * (4 * sub + j) + i;
#pragma unroll
            for (int q = 0; q < 4; ++q) {
                const int p = n * 32 + 8 * q + 4 * g;
                const u32x2 xr = *(const LAS u32x2*)(Zc + zaddr(b00 + j * bstep, q) + 8 * g);
                u32x2 w; w.x = cvt_pk_bf16(acc[j][4 * q] * bflo(xr.x), acc[j][4 * q + 1] * bfhi(xr.x)); w.y = cvt_pk_bf16(acc[j][4 * q + 2] * bflo(xr.y), acc[j][4 * q + 3] * bfhi(xr.y));
                *(u32x2*)(orow + p) = w;
            }
        }
    }
    __syncthreads();
#undef ZPOS
}

__device__ __forceinline__ void phase_transpose_ob(LAS unsigned char* lds, const Ctx& C) {
    const u16* src = (const u16*)C.out; u16* dst = (u16*)(C.ws + WS_LFF);
    LAS u16* tl = (LAS u16*)lds;
    const int tid = threadIdx.x, r8 = tid >> 3, pc = tid & 7;
    for (int t4 = blockIdx.x; t4 < 16 * 64; t4 += gridDim.x) {
        const int c0 = (t4 >> 6) * 64, k00 = (t4 & 63) * 256;
        u32x4 v[4];
#pragma unroll
        for (int q = 0; q < 4; ++q) v[q] = *(const u32x4*)(src + (size_t)(c0 + r8) * T + k00 + 64 * q + 8 * pc);
#pragma unroll
        for (int q = 0; q < 4; ++q) { LAS unsigned* wp = (LAS unsigned*)(tl + q * 4224 + r8 * 66 + 8 * pc); wp[0] = v[q].x; wp[1] = v[q].y; wp[2] = v[q].z; wp[3] = v[q].w; }
        __syncthreads();
#pragma unroll
        for (int q = 0; q < 4; ++q) {
            unsigned o[4];
#pragma unroll
            for (int e = 0; e < 4; ++e) o[e] = (unsigned)tl[q * 4224 + (8 * pc + 2 * e) * 66 + r8] | ((unsigned)tl[q * 4224 + (8 * pc + 2 * e + 1) * 66 + r8] << 16);
            u32x4 w; w.x = o[0]; w.y = o[1]; w.z = o[2]; w.w = o[3];
            *(u32x4*)(dst + (size_t)(k00 + 64 * q + r8) * D + c0 + 8 * pc) = w;
        }
        __syncthreads();
    }
}

constexpr int SC_QIN = 0, SC_KIN = 8704, SC_KST = 17408, SC_VT = 27648, SC_DEC = 37888, SC_BUF = 38400, SC_HALF = 2 * SC_BUF;

__device__ __forceinline__ void scan_unit(LAS unsigned char* lds_all, const Ctx& C, int pseq, int h, int mode) {
    const int tid = threadIdx.x, dir = tid >> 8, lane = tid & 63, beta = (tid >> 6) & 3, r = lane & 31, hh = lane >> 5;
    const bool want_out = (mode != 1);
    LAS unsigned char* ldsh = lds_all + dir * SC_HALF;
    const u16* Q = (const u16*)(C.ws + WS_Q); const u16* V = (const u16*)(C.ws + WS_V);
    u16* LF = (u16*)(C.ws + (dir ? WS_LFB : WS_LFF));
    float* SEGF = (float*)(C.ws + WS_HB); float* SEGD = (float*)(C.ws + WS_SEGD);
    const int tok_base = pseq * 256, col0 = h * 128;
    const int a_p = 32 * beta + r, rh = hh;

    f32x16 S[4];
#pragma unroll
    for (int al = 0; al < 4; ++al)
#pragma unroll
        for (int e = 0; e < 16; ++e) S[al][e] = 0.f;
    if (mode == 2) {
        const float* s0 = SEGF + (size_t)(((pseq - 32) * 8 + h) * 2 + dir) * 16384;
#pragma unroll
        for (int al = 0; al < 4; ++al)
#pragma unroll
            for (int e = 0; e < 16; ++e) S[al][e] = s0[(32 * al + rowmap(e, hh)) * 128 + 32 * beta + r];
    }
    float dsum = 0.f;
    u16 rl[16], rq[16] = {}, rv[16];
    const u16* Qb = Q + (size_t)tok_base * D + col0; const u16* Vb = V + (size_t)tok_base * D + col0; u16* LFb = LF + (size_t)tok_base * D + col0;
    const int stepD = dir ? -D : D, prow0 = dir ? 31 - 16 * rh : 16 * rh;
#define SCAN_LOAD(nc) do { const int cidx_ = dir ? 7 - (nc) : (nc); const int o_ = (32 * cidx_ + prow0) * D + a_p; \
        _Pragma("unroll") for (int pp = 0; pp < 16; ++pp) { rl[pp] = LFb[(unsigned)(o_ + pp * stepD)]; if (want_out) rq[pp] = Qb[(unsigned)(o_ + pp * stepD)]; rv[pp] = Vb[(unsigned)(o_ + pp * stepD)]; } } while (0)
#define SCAN_PREP(bufp) do { LAS unsigned char* lb_ = (bufp); float b_[16]; float run_ = 0.f; \
        _Pragma("unroll") for (int pp = 0; pp < 16; ++pp) { run_ += (float)__builtin_bit_cast(_Float16, rl[pp]); b_[pp] = run_; } \
        const float other_ = __shfl_xor(run_, 32, 64), blast_ = run_ + other_, dect_ = __expf(blast_), badd_ = rh ? other_ : 0.f; \
        float kst_[16]; \
        _Pragma("unroll") for (int pp = 0; pp < 16; ++pp) { \
            const float kk_ = 1.f - __expf((float)__builtin_bit_cast(_Float16, rl[pp])); \
            const float eb_ = __expf(b_[pp] + badd_), kin_ = kk_ * __builtin_amdgcn_rcpf(eb_); const int p_ = 16 * rh + pp; \
            if (want_out) { *(LAS u16*)(lb_ + SC_QIN + p_ * 272 + a_p * 2) = f2bf(bf2f(rq[pp]) * eb_); \
                            *(LAS u16*)(lb_ + SC_KIN + p_ * 272 + a_p * 2) = f2bf(kin_); } \
            kst_[pp] = kin_ * dect_; } \
        u32x4 w0_, w1_; \
        w0_.x = cvt_pk_bf16(kst_[0], kst_[1]); w0_.y = cvt_pk_bf16(kst_[2], kst_[3]); w0_.z = cvt_pk_bf16(kst_[4], kst_[5]); w0_.w = cvt_pk_bf16(kst_[6], kst_[7]); \
        w1_.x = cvt_pk_bf16(kst_[8], kst_[9]); w1_.y = cvt_pk_bf16(kst_[10], kst_[11]); w1_.z = cvt_pk_bf16(kst_[12], kst_[13]); w1_.w = cvt_pk_bf16(kst_[14], kst_[15]); \
        *(LAS u32x4*)(lb_ + SC_KST + a_p * 80 + 32 * rh) = w0_; *(LAS u32x4*)(lb_ + SC_KST + a_p * 80 + 32 * rh + 16) = w1_; \
        w0_.x = rv[0] | ((unsigned)rv[1] << 16); w0_.y = rv[2] | ((unsigned)rv[3] << 16); w0_.z = rv[4] | ((unsigned)rv[5] << 16); w0_.w = rv[6] | ((unsigned)rv[7] << 16); \
        w1_.x = rv[8] | ((unsigned)rv[9] << 16); w1_.y = rv[10] | ((unsigned)rv[11] << 16); w1_.z = rv[12] | ((unsigned)rv[13] << 16); w1_.w = rv[14] | ((unsigned)rv[15] << 16); \
        *(LAS u32x4*)(lb_ + SC_VT + a_p * 80 + 32 * rh) = w0_; *(LAS u32x4*)(lb_ + SC_VT + a_p * 80 + 32 * rh + 16) = w1_; \
        if (rh == 0) { ((LAS float*)(lb_ + SC_DEC))[a_p] = dect_; dsum += blast_; } } while (0)
    SCAN_LOAD(0);
    SCAN_PREP(ldsh);
    __syncthreads();
    for (int nchunk = 0; nchunk < 8; ++nchunk) {
        const int cidx = dir ? 7 - nchunk : nchunk;
        LAS unsigned char* lds = ldsh + (nchunk & 1) * SC_BUF;
        if (nchunk < 7) SCAN_LOAD(nchunk + 1);
        if (want_out) {
            f32x16 accP;
#pragma unroll
            for (int e = 0; e < 16; ++e) accP[e] = 0.f;
#pragma unroll
            for (int kk = 0; kk < 8; ++kk) {
                const bf16x8 A = *(const LAS bf16x8*)(lds + SC_KIN + r * 272 + 32 * kk + 16 * hh);
                const bf16x8 B = *(const LAS bf16x8*)(lds + SC_QIN + r * 272 + 32 * kk + 16 * hh);
                accP = mfma32(A, B, accP);
            }
#pragma unroll
            for (int e = 0; e < 16; ++e) if (rowmap(e, hh) > r) accP[e] = 0.f;
            f32x16 acco;
#pragma unroll
            for (int e = 0; e < 16; ++e) acco[e] = 0.f;
#pragma unroll
            for (int st = 0; st < 2; ++st) {
                const bf16x8 Pf = pack8(accP[8 * st], accP[8 * st + 1], accP[8 * st + 2], accP[8 * st + 3], accP[8 * st + 4], accP[8 * st + 5], accP[8 * st + 6], accP[8 * st + 7]);
                const bf16x4 lo = *(const LAS bf16x4*)(lds + SC_VT + (32 * beta + r) * 80 + 32 * st + 8 * hh);
                const bf16x4 hi = *(const LAS bf16x4*)(lds + SC_VT + (32 * beta + r) * 80 + 32 * st + 16 + 8 * hh);
                const bf16x8 Bv = (bf16x8){lo[0], lo[1], lo[2], lo[3], hi[0], hi[1], hi[2], hi[3]};
                acco = mfma32(Pf, Bv, acco);
            }
#pragma unroll
            for (int al = 0; al < 4; ++al)
#pragma unroll
                for (int st = 0; st < 2; ++st) {
                    const bf16x4 lo = *(const LAS bf16x4*)(lds + SC_QIN + r * 272 + (32 * al + 16 * st + 4 * hh) * 2);
                    const bf16x4 hi = *(const LAS bf16x4*)(lds + SC_QIN + r * 272 + (32 * al + 16 * st + 8 + 4 * hh) * 2);
                    const bf16x8 Aq = (bf16x8){lo[0], lo[1], lo[2], lo[3], hi[0], hi[1], hi[2], hi[3]};
                    const bf16x8 Bs = pack8(S[al][8 * st], S[al][8 * st + 1], S[al][8 * st + 2], S[al][8 * st + 3], S[al][8 * st + 4], S[al][8 * st + 5], S[al][8 * st + 6], S[al][8 * st + 7]);
                    acco = mfma32(Aq, Bs, acco);
                }
            { const int ob = (32 * cidx + (dir ? 31 - 4 * hh : 4 * hh)) * D + 32 * beta + r;
#pragma unroll
              for (int e = 0; e < 16; ++e) LFb[(unsigned)(ob + ((e & 3) + 8 * (e >> 2)) * stepD)] = f2bf(acco[e]); }
        }
#pragma unroll
        for (int al = 0; al < 4; ++al) {
#pragma unroll
            for (int q = 0; q < 4; ++q) {
                const f32x4 d4 = *(const LAS f32x4*)(lds + SC_DEC + (32 * al + 8 * q + 4 * hh) * 4);
#pragma unroll
                for (int e = 0; e < 4; ++e) S[al][4 * q + e] *= d4[e];
            }
#pragma unroll
            for (int st = 0; st < 2; ++st) {
                const bf16x8 A = *(const LAS bf16x8*)(lds + SC_KST + (32 * al + r) * 80 + 32 * st + 16 * hh);
                const bf16x8 B = *(const LAS bf16x8*)(lds + SC_VT + (32 * beta + r) * 80 + 32 * st + 16 * hh);
                S[al] = mfma32(A, B, S[al]);
            }
        }
        if (nchunk < 7) SCAN_PREP(ldsh + ((nchunk + 1) & 1) * SC_BUF);
        __syncthreads();
    }
#undef SCAN_LOAD
#undef SCAN_PREP
    if (mode == 0) {
        float* ns = C.out + (size_t)T * D + (size_t)((pseq * 2 + dir) * 8 + h) * 16384;
#pragma unroll
        for (int al = 0; al < 4; ++al)
#pragma unroll
            for (int e = 0; e < 16; ++e) ns[(32 * al + rowmap(e, hh)) * 128 + 32 * beta + r] = S[al][e];
    } else if (mode == 1) {
        const int seg = pseq - 32;
        float* Fp = SEGF + (size_t)((seg * 8 + h) * 2 + dir) * 16384;
#pragma unroll
        for (int al = 0; al < 4; ++al)
#pragma unroll
            for (int e = 0; e < 16; ++e) Fp[(32 * al + rowmap(e, hh)) * 128 + 32 * beta + r] = S[al][e];
        if (rh == 0) SEGD[(size_t)((seg * 8 + h) * 2 + dir) * 128 + a_p] = __expf(dsum);
    }
    if (want_out) {
        __syncthreads();
        const u16* OF = (const u16*)(C.ws + WS_LFF); const u16* OBk = (const u16*)(C.ws + WS_LFB); u16* G = (u16*)(C.ws + WS_G);
        const int l16 = tid & 15, trow = tid >> 4, v0 = 8 * l16;
        const f32x4 nw0 = *(const f32x4*)(C.in[9] + v0), nw1 = *(const f32x4*)(C.in[9] + v0 + 4);
        const float nw[8] = {nw0[0], nw0[1], nw0[2], nw0[3], nw1[0], nw1[1], nw1[2], nw1[3]};
#pragma unroll
        for (int ib = 0; ib < 2; ++ib) {
            u32x4 fv[4], bv[4], gv4[4];
#pragma unroll
            for (int it = 0; it < 4; ++it) { const size_t idx = (size_t)(tok_base + trow + 32 * (4 * ib + it)) * D + col0 + v0;
                fv[it] = *(const u32x4*)(OF + idx); bv[it] = *(const u32x4*)(OBk + idx); gv4[it] = *(const u32x4*)(G + idx); }
#pragma unroll
            for (int it = 0; it < 4; ++it) {
                const size_t idx = (size_t)(tok_base + trow + 32 * (4 * ib + it)) * D + col0 + v0;
                const u32x4 f = fv[it], bk = bv[it], gg = gv4[it];
                float o[8] = {bflo(f.x) + bflo(bk.x), bfhi(f.x) + bfhi(bk.x), bflo(f.y) + bflo(bk.y), bfhi(f.y) + bfhi(bk.y),
                              bflo(f.z) + bflo(bk.z), bfhi(f.z) + bfhi(bk.z), bflo(f.w) + bflo(bk.w), bfhi(f.w) + bfhi(bk.w)};
                const float gv[8] = {bflo(gg.x), bfhi(gg.x), bflo(gg.y), bfhi(gg.y), bflo(gg.z), bfhi(gg.z), bflo(gg.w), bfhi(gg.w)};
                float ss = 0.f;
#pragma unroll
                for (int e = 0; e < 8; ++e) ss += o[e] * o[e];
#pragma unroll
                for (int of = 8; of >= 1; of >>= 1) ss += __shfl_xor(ss, of, 64);
                const float rinv = rsqrtf(ss * (1.f / 128.f) + 1e-6f);
#pragma unroll
                for (int e = 0; e < 8; ++e) o[e] = o[e] * rinv * nw[e] * gv[e];
                u32x4 w; w.x = cvt_pk_bf16(o[0], o[1]); w.y = cvt_pk_bf16(o[2], o[3]); w.z = cvt_pk_bf16(o[4], o[5]); w.w = cvt_pk_bf16(o[6], o[7]);
                *(u32x4*)(G + idx) = w;
            }
        }
    }
    __syncthreads();
}

__device__ __forceinline__ void phase_prefix(const Ctx& C) {
    float* SEGF = (float*)(C.ws + WS_HB); const float* SEGD = (const float*)(C.ws + WS_SEGD);
    for (int v = blockIdx.x * 512 + threadIdx.x; v < 32 * 4096; v += gridDim.x * 512) {
        const int chain = v >> 12, e4 = v & 4095, a = e4 >> 5;
        const int sq = chain >> 4, h = (chain >> 1) & 7, dir = chain & 1;
        f32x4 s = *(const f32x4*)(C.in[2] + (size_t)((sq * 2 + dir) * 8 + h) * 16384 + 4 * e4);
#pragma unroll 8
        for (int i = 0; i < 16; ++i) {
            const int seg = sq * 16 + (dir ? 15 - i : i);
            float* fp = SEGF + (size_t)((seg * 8 + h) * 2 + dir) * 16384 + 4 * e4;
            const f32x4 f = *(const f32x4*)fp; const float d = SEGD[(size_t)((seg * 8 + h) * 2 + dir) * 128 + a];
            *(f32x4*)fp = s;
            s = d * s + f;
        }
    }
}

#define XB_TMO      128
#define XB_XCNT(j)  (256  + 64 * (j))
#define XB_XSUB(j)  (1280 + 64 * (j))
#define XB_XGEN(j)  (2304 + 64 * (j))
#define XB_TOP      3328
#define XB_TOPGEN   3392
#define XCD_BAR_WORDS 3456
#define XB_SPIN_CAP (1u << 18)
__device__ __forceinline__ unsigned xb_ld(unsigned* p)              { return __hip_atomic_load(p, __ATOMIC_RELAXED, __HIP_MEMORY_SCOPE_AGENT); }
__device__ __forceinline__ unsigned xb_add(unsigned* p, unsigned v) { return __hip_atomic_fetch_add(p, v, __ATOMIC_RELAXED, __HIP_MEMORY_SCOPE_AGENT); }
__device__ __forceinline__ unsigned xb_xcc_id() { return (unsigned)__builtin_amdgcn_s_getreg((3 << 11) | 20) & 0xFu; }
#define XB_SPIN(cond, bar) do { unsigned _sp = 0; while (cond) { __builtin_amdgcn_s_sleep(1); \
    if ((++_sp & 255u) == 0u) { if (xb_ld(&(bar)[XB_TMO])) break; if (_sp > XB_SPIN_CAP) { atomicAdd(&(bar)[XB_TMO], 1u); break; } } } } while (0)
struct XcdBarrier { unsigned* bar; unsigned x; volatile LAS unsigned* st; };
__device__ __forceinline__ XcdBarrier xcd_barrier_post(unsigned* bar, volatile LAS unsigned* st) {
    XcdBarrier b; b.bar = bar; b.x = xb_xcc_id(); b.st = st;
    if (threadIdx.x == 0) (void)xb_add(&bar[XB_XCNT(b.x)], 1u);
    return b;
}
__device__ __forceinline__ void xcd_barrier_complete(unsigned* bar, unsigned x, unsigned& nloc, unsigned& nx) {
    const unsigned G = gridDim.x * gridDim.y * gridDim.z;
    unsigned sum, cnt, mine, sp = 0u;
    for (;;) {
        sum = 0u; cnt = 0u; mine = 0u;
#pragma unroll
        for (unsigned j = 0; j < 16; ++j) { const unsigned c = xb_ld(&bar[XB_XCNT(j)]); sum += c; cnt += (c > 0u) ? 1u : 0u; mine = (j == x) ? c : mine; }
        if (sum == G) break;
        __builtin_amdgcn_s_sleep(1);
        if ((++sp & 255u) == 0u) { if (xb_ld(&bar[XB_TMO])) break; if (sp > XB_SPIN_CAP) { atomicAdd(&bar[XB_TMO], 1u); break; } }
    }
    nloc = mine > 0u ? mine : 1u; nx = cnt > 0u ? cnt : 1u;
}
__device__ __forceinline__ void xcd_barrier(const XcdBarrier& b) {
    asm volatile("s_waitcnt vmcnt(0)" ::: "memory");
    __syncthreads();
    if (threadIdx.x == 0) {
        unsigned* bar = b.bar;
        __builtin_amdgcn_s_waitcnt(0);
        unsigned nloc = b.st[0], nx = b.st[1];
        if (nloc == 0u) { xcd_barrier_complete(bar, b.x, nloc, nx); b.st[0] = nloc; b.st[1] = nx; }
        const unsigned old = xb_add(&bar[XB_XSUB(b.x)], 1u);
        const unsigned gen = old / nloc;
        if (old + 1u == (gen + 1u) * nloc) {
            __builtin_amdgcn_fence(__ATOMIC_RELEASE, "agent");
            asm volatile("s_waitcnt vmcnt(0)" ::: "memory");
            const unsigned og = xb_add(&bar[XB_TOP], 1u);
            const unsigned tg = og / nx;
            if (og + 1u == (tg + 1u) * nx) xb_add(&bar[XB_TOPGEN], 1u);
            else XB_SPIN(xb_ld(&bar[XB_TOPGEN]) == tg, bar);
            __builtin_amdgcn_fence(__ATOMIC_ACQUIRE, "agent");
            xb_add(&bar[XB_XGEN(b.x)], 1u);
            asm volatile("s_waitcnt vmcnt(0)" ::: "memory");
        } else {
            XB_SPIN(xb_ld(&bar[XB_XGEN(b.x)]) == gen, bar);
            __builtin_amdgcn_fence(__ATOMIC_ACQUIRE, "agent");
            asm volatile("s_waitcnt vmcnt(0)" ::: "memory");
        }
    }
    __syncthreads();
}

constexpr int N_PHASES = 15;
__global__ void __launch_bounds__(512, 2) mega_fwd(Params P) {
    extern __shared__ __attribute__((aligned(16))) unsigned char lds_raw[];
    LAS unsigned char* lds = (LAS unsigned char*)lds_raw;
    cg::grid_group grid = cg::this_grid();
    Ctx C;
#pragma unroll
    for (int i = 0; i < 30; ++i) C.in[i] = P.in[i];
    C.out = P.out; C.ws = P.ws;
    unsigned char* ws = P.ws;
    const int lo = P.ph_lo, hi = P.ph_hi;
    const int G = gridDim.x, bid = blockIdx.x;
    volatile LAS unsigned* xbw = (volatile LAS unsigned*)(lds + LDS_XB_OFF);
    if (threadIdx.x < 4) xbw[threadIdx.x] = 0u;
    __syncthreads();
    XcdBarrier xbar = xcd_barrier_post((unsigned*)(ws + WS_BAR), xbw);
#ifndef PHM
#define PHM 0x7fff
#endif
#define IN(k) (((PHM >> (k)) & 1) && lo <= (k) && (k) < hi)
#ifndef REPEAT_MASK
#define REPEAT_MASK 0
#endif
#define NREP(k) ((((REPEAT_MASK) >> (k)) & 1) ? 2 : 1)
#define SEAM(k) do { if (IN(k) && IN((k) + 1)) { if (hi > 1000) grid.sync(); else xcd_barrier(xbar); } } while (0)

    if (IN(0)) for (int rep_ = 0; rep_ < NREP(0); ++rep_) { phase_prep(lds, C); }
    SEAM(0);
    if (IN(1)) for (int rep_ = 0; rep_ < NREP(1); ++rep_) { phase_modulate(C); }
    SEAM(1);
    if (IN(2)) for (int rep_ = 0; rep_ < NREP(2); ++rep_) {
        pg8::Gemm g{1024, (size_t)128 * 1024 * 2, (size_t)128 * 1024 * 2};
        pg8::Sched S{}; S.nM = 12; S.nN = 64; S.nwg = 768; S.G = G; S.c = bid; S.kind = 0;
        S.A = (const char*)(ws + WS_WIN) + (size_t)5120 * 2048; S.B = (const char*)(ws + WS_HB); S.tsA = (size_t)256 * 2048; S.tsB = (size_t)256 * 2048;
        EpiBf E{(u16*)(ws + WS_R60), T};
        pg8::gemm_phase<EpiBf>(lds, g, S, E);
    }
    SEAM(2);
    if (IN(3)) for (int rep_ = 0; rep_ < NREP(3); ++rep_) { for (int u = bid; u < 512; u += G) conv_unit(lds, C, u >> 8, u & 255); }
    SEAM(3);
    if (IN(4)) for (int rep_ = 0; rep_ < NREP(4); ++rep_) {
        pg8::Gemm g{1024, (size_t)128 * 1024 * 2, (size_t)128 * 1024 * 2};
        pg8::Sched S{}; S.nM = 64; S.nN = 28; S.nwg = 1792; S.G = G; S.c = bid; S.kind = 1;
        S.A = (const char*)(ws + WS_HB); S.B = (const char*)(ws + WS_WIN); S.tsA = (size_t)256 * 2048; S.tsB = 0;
        EpiIn E; E.out[0] = (u16*)(ws + WS_Q); E.out[1] = (u16*)(ws + WS_LFF); E.out[2] = (u16*)(ws + WS_LFB); E.out[3] = (u16*)(ws + WS_V);
        E.out[4] = (u16*)(ws + WS_G); E.out[5] = (u16*)(ws + WS_GA); E.out[6] = (u16*)((unsigned char*)P.out + 32 * MiB); E.LB = (const float*)(ws + WS_LB);
        pg8::gemm_phase<EpiIn>(lds, g, S, E);
    }
    SEAM(4);
    if (IN(5)) for (int rep_ = 0; rep_ < NREP(5); ++rep_) {
        for (int u = bid; u < 512; u += G) { if (u < 256) scan_unit(lds, C, u >> 3, u & 7, 0); else scan_unit(lds, C, 32 + ((u - 256) >> 3), u & 7, 1); }
    }
    SEAM(5);
    if (IN(6)) { phase_prefix(C); }
    SEAM(6);
    if (IN(7)) for (int rep_ = 0; rep_ < NREP(7); ++rep_) { for (int u = bid; u < 256; u += G) scan_unit(lds, C, 32 + (u >> 3), u & 7, 2); }
    SEAM(7);
    if (IN(8)) for (int rep_ = 0; rep_ < NREP(8); ++rep_) { phase_transpose_ob(lds, C); }
    SEAM(8);
    if (IN(9)) for (int rep_ = 0; rep_ < NREP(9); ++rep_) {
        pg8::Gemm g{1024, (size_t)128 * 1024 * 2, (size_t)128 * 1024 * 2};
        pg8::Sched S{}; S.nM = 64; S.nN = 4; S.nwg = 256; S.G = G; S.c = bid; S.kind = 2;
        S.A = (const char*)(ws + WS_G); S.A2 = (const char*)(ws + WS_LFF); S.B = (const char*)(ws + WS_WPA); S.B2 = (const char*)(ws + WS_WPB); S.tsA = (size_t)256 * 2048; S.tsB = (size_t)256 * 2048;
        EpiMerge E{(const u16*)(ws + WS_GA), (const u16*)((unsigned char*)P.out + 32 * MiB), (u16*)(ws + WS_T1)};
        pg8::gemm_phase<EpiMerge>(lds, g, S, E);
    }
    SEAM(9);
    if (IN(10)) for (int rep_ = 0; rep_ < NREP(10); ++rep_) {
        pg8::Gemm g{1024, (size_t)128 * 1024 * 2, (size_t)128 * 1024 * 2};
        pg8::Sched S{}; S.nM = 64; S.nN = 4; S.nwg = 256; S.G = G; S.c = bid; S.kind = 0;
        S.A = (const char*)(ws + WS_T1); S.B = (const char*)(ws + WS_WOUT); S.tsA = (size_t)256 * 2048; S.tsB = (size_t)256 * 2048;
        EpiRes<false> E{P.in[0], P.in[1], (const float*)(ws + WS_MOD) + 2 * 1024, (u16*)(ws + WS_U1)};
        pg8::gemm_phase<EpiRes<false>>(lds, g, S, E);
    }
    SEAM(10);
    if (IN(11)) for (int rep_ = 0; rep_ < NREP(11); ++rep_) {
        phase_ln<true>(C, (const u16*)(ws + WS_U1), nullptr, (u16*)(ws + WS_X1), P.in[24], P.in[25], (u16*)(ws + WS_HB), 4, 3);
        __syncthreads();
        for (int u = bid; u < 352; u += G) convert_tile4(lds, P.in[26], (u16*)(ws + WS_WFIN), 1024, 2 * DFF, u);
        if (G != 256) for (int u = bid; u < 176; u += G) convert_tile4(lds, P.in[27], (u16*)(ws + WS_WFOUT), DFF, 1024, u);
    }
    SEAM(11);
    if (IN(12)) for (int rep_ = 0; rep_ < NREP(12); ++rep_) {
        pg8::Gemm g{1024, (size_t)128 * 1024 * 2, (size_t)DFF * 1024 * 2};
        pg8::Sched S{}; S.nM = 64; S.nN = 22; S.nwg = 1408; S.G = G; S.c = bid; S.kind = 0;
        S.A = (const char*)(ws + WS_HB); S.B = (const char*)(ws + WS_WFIN); S.tsA = (size_t)256 * 2048; S.tsB = (size_t)128 * 2048;
        EpiGlu E{(u16*)(ws + WS_FF)};
        pg8::gemm_phase<EpiGlu>(lds, g, S, E);
        if (G == 256 && bid >= 128) for (int u = bid - 128; u < 176; u += 128) convert_tile4(lds, P.in[27], (u16*)(ws + WS_WFOUT), DFF, 1024, u);
    }
    SEAM(12);
    if (IN(13)) for (int rep_ = 0; rep_ < NREP(13); ++rep_) {
        pg8::Gemm g{DFF, (size_t)128 * DFF * 2, (size_t)128 * DFF * 2};
        pg8::Sched S{}; S.nM = 64; S.nN = 4; S.nwg = 256; S.G = G; S.c = bid; S.kind = 0;
        S.A = (const char*)(ws + WS_FF); S.B = (const char*)(ws + WS_WFOUT); S.tsA = (size_t)256 * DFF * 2; S.tsB = (size_t)256 * DFF * 2;
        EpiRes<true> E{(const void*)(ws + WS_X1), nullptr, (const float*)(ws + WS_MOD) + 5 * 1024, (u16*)(ws + WS_HB)};
        pg8::gemm_phase<EpiRes<true>>(lds, g, S, E);
    }
    SEAM(13);
    if (IN(14)) for (int rep_ = 0; rep_ < NREP(14); ++rep_) { phase_ln<false>(C, (const u16*)(ws + WS_HB), P.out, nullptr, P.in[28], P.in[29], nullptr, 0, 0); }
#ifdef DEBUG_SANITIZE
    if (lo == 15) {
        const unsigned* w32 = (const unsigned*)P.ws; unsigned* o32 = (unsigned*)P.out;
        const size_t n = (size_t)T * D, nall = n + 8388608;
        for (size_t i = (size_t)bid * 512 + threadIdx.x; i < nall; i += (size_t)G * 512) {
            unsigned w = o32[i];
#ifdef DEBUG_FOLD
            if (i < n) w ^= w32[i] ^ w32[i + n] ^ w32[i + 2 * n] ^ w32[i + 3 * n];
#endif
            float v = __uint_as_float(w); if (!(fabsf(v) < 1e30f)) v = 0.f;
            P.out[i] = v;
        }
    }
#endif
#undef IN
#undef SEAM
}

extern "C" void kernel_launch(void* const* d_in, const int* in_sizes, int n_in, void* d_out, int out_size, void* d_ws, size_t ws_size, hipStream_t stream) {
    static int grid_blocks = 0;
    if (!grid_blocks) {
        int dev = 0, cus = 0, per_cu = 0;
        hipGetDevice(&dev);
        hipDeviceGetAttribute(&cus, hipDeviceAttributeMultiprocessorCount, dev);
        hipFuncSetAttribute((const void*)mega_fwd, hipFuncAttributeMaxDynamicSharedMemorySize, LDS_BYTES);
        hipOccupancyMaxActiveBlocksPerMultiprocessor(&per_cu, (const void*)mega_fwd, 512, LDS_BYTES);
        if (per_cu < 1) { fprintf(stderr, "occupancy query says %d blocks per CU\n", per_cu); per_cu = 1; }
        if (per_cu > 1) per_cu = 1;
        grid_blocks = cus * per_cu;
        (void)hipGetLastError();
    }
    Params p{};
    for (int i = 0; i < 30; ++i) p.in[i] = (const float*)d_in[i];
    p.out = (float*)d_out; p.ws = (unsigned char*)d_ws;
#if SPLIT_LAUNCH
#ifndef PH_END
#define PH_END N_PHASES
#endif
#ifdef DEBUG_SANITIZE
    const int n_launch = 16;
#else
    const int n_launch = PH_END;
#endif
    for (int ph = 0; ph < n_launch; ++ph) {
        if (ph >= PH_END && ph < 15) continue;
        p.ph_lo = ph; p.ph_hi = ph + 1;
        hipLaunchKernelGGL(mega_fwd, dim3(grid_blocks), dim3(512), LDS_BYTES, stream, p);
    }
#else
    p.ph_lo = 0; p.ph_hi = N_PHASES;
    (void)hipMemsetAsync((char*)d_ws + WS_BAR, 0, XCD_BAR_WORDS * sizeof(unsigned), stream);
    void* args[] = {&p};
    hipError_t e = hipLaunchCooperativeKernel((const void*)mega_fwd, dim3(grid_blocks), dim3(512), args, LDS_BYTES, stream);
    if (e != hipSuccess) fprintf(stderr, "cooperative launch failed: %s (grid %d)\n", hipGetErrorString(e), grid_blocks);
#endif
}
```

```cpp
#include <hip/hip_runtime.h>
#include <hip/hip_cooperative_groups.h>
#include <cstdio>
namespace cg = cooperative_groups;

#define CONV_REP_MAIN 1
#ifndef SPLIT_LAUNCH
#define SPLIT_LAUNCH 0
#endif

#define LAS __attribute__((address_space(3)))
typedef unsigned short u16;
typedef short bf16x8 __attribute__((ext_vector_type(8)));
typedef short bf16x4 __attribute__((ext_vector_type(4)));
typedef float f32x4 __attribute__((ext_vector_type(4)));
typedef float f32x16 __attribute__((ext_vector_type(16)));
typedef unsigned u32x4 __attribute__((ext_vector_type(4)));
typedef unsigned u32x2 __attribute__((ext_vector_type(2)));
typedef _Float16 h16x2 __attribute__((ext_vector_type(2)));

constexpr int T = 16384, D = 1024, NIN = 10240, DFF = 2816, NMOD = 6144;
constexpr size_t MiB = 1u << 20;
constexpr int LDS_BYTES = 155648 + 64;
constexpr int LDS_XB_OFF = 155648;
constexpr float ALPHA = 1.189207115002721f;

constexpr size_t WS_WIN = 0, WS_WPA = 20 * MiB, WS_WPB = 22 * MiB, WS_WOUT = 24 * MiB;
constexpr size_t WS_MISC = 26 * MiB;
constexpr size_t WS_MOD = WS_MISC, WS_LB = WS_MISC + 128 * 1024, WS_H3P = WS_MISC + 256 * 1024, WS_H3S = WS_MISC + 512 * 1024, WS_SEGD = WS_MISC + 1536 * 1024, WS_BAR = WS_MISC + 1792 * 1024;
constexpr size_t WS_HB = 28 * MiB;
constexpr size_t WS_R60 = 60 * MiB;
constexpr size_t WS_Q = 60 * MiB, WS_LFF = 92 * MiB, WS_LFB = 124 * MiB, WS_V = 156 * MiB, WS_G = 188 * MiB, WS_GA = 220 * MiB;
constexpr size_t WS_T1 = 60 * MiB, WS_U1 = 92 * MiB, WS_X1 = 156 * MiB, WS_FF = 60 * MiB, WS_WFIN = 220 * MiB, WS_WFOUT = 232 * MiB;

struct Params { const float* in[30]; float* out; unsigned char* ws; int ph_lo, ph_hi; };

struct Ctx {
    const float* in[30]; float* out; unsigned char* ws;
    __device__ __forceinline__ const float* xrow(int tok) const { return tok < 8192 ? in[0] + (size_t)tok * D : in[1] + (size_t)(tok - 8192) * D; }
};
__device__ __forceinline__ int cid_of(int tok) { return tok < 8192 ? 0 : 1 + ((tok - 8192) >> 12); }

typedef __bf16 bf16v2 __attribute__((ext_vector_type(2)));
typedef float f32x2 __attribute__((ext_vector_type(2)));
__device__ __forceinline__ unsigned cvt_pk_bf16(float lo, float hi) { f32x2 v = {lo, hi}; bf16v2 b = __builtin_convertvector(v, bf16v2); return __builtin_bit_cast(unsigned, b); }
__device__ __forceinline__ float bf2f(u16 b) { return __uint_as_float(((unsigned)b) << 16); }
__device__ __forceinline__ float bflo(unsigned w) { return __uint_as_float(w << 16); }
__device__ __forceinline__ float bfhi(unsigned w) { return __uint_as_float(w & 0xffff0000u); }
__device__ __forceinline__ u16 f2bf(float f) { return (u16)(cvt_pk_bf16(f, 0.f) & 0xffffu); }
__device__ __forceinline__ float sigmoid_f(float x) { return __builtin_amdgcn_rcpf(1.f + __expf(-x)); }
__device__ __forceinline__ float silu_f(float x) { return x * __builtin_amdgcn_rcpf(1.f + __expf(-x)); }
__device__ __forceinline__ float red2pi(float x) { const float k = rintf(x * 0.15915494309189535f); float r = fmaf(-k, 6.2831854820251465f, x); return fmaf(k, 1.7484555e-7f, r); }
__device__ __forceinline__ float my_sin(float x) { return __sinf(red2pi(x)); }
__device__ __forceinline__ float my_cos(float x) { return __cosf(red2pi(x)); }
__device__ __forceinline__ int rowmap(int reg, int hh) { return (reg & 3) + 8 * (reg >> 2) + 4 * hh; }
__device__ __forceinline__ f32x16 mfma32(bf16x8 a, bf16x8 b, f32x16 c) { return __builtin_amdgcn_mfma_f32_32x32x16_bf16(a, b, c, 0, 0, 0); }
__device__ __forceinline__ bf16x8 pack8(float a0, float a1, float a2, float a3, float a4, float a5, float a6, float a7) {
    u32x4 w; w.x = cvt_pk_bf16(a0, a1); w.y = cvt_pk_bf16(a2, a3); w.z = cvt_pk_bf16(a4, a5); w.w = cvt_pk_bf16(a6, a7);
    return __builtin_bit_cast(bf16x8, w);
}

namespace pg8 {
constexpr int BM = 256, BK = 64, HALF = 128, HTB = HALF * BK * 2, STAGE_BYTES = 8 * HTB, NXCD = 8, WGM = 4;
__device__ __forceinline__ int lds_byte(int r, int c) { const int st = (r >> 4) * 2 + (c >> 5), rr = r & 15, cc = c & 31, ob = rr * 64 + cc * 2; return st * 1024 + (ob ^ (((ob >> 9) & 1) << 5)); }
__device__ __forceinline__ void stage_rc(int b, int& R, int& C) { const int st = b / 1024, sb = b % 1024, swz = sb ^ (((sb >> 9) & 1) << 5); R = (st >> 1) * 16 + swz / 64; C = (st & 1) * 32 + (swz % 64) / 2; }
__device__ __forceinline__ int perm32(int rho) { const int n = rho >> 4, i = rho & 15; return 8 * (i >> 2) + 4 * n + (i & 3); }

struct Unit { const char* A; const char* B; int pm, pn, aux, pad; };
struct Gemm { int K; size_t hstepA, hstepB; };

struct Sched {
    int nM, nN, nwg, G, c, kind;
    const char* A; const char* B; const char* A2; const char* B2; size_t tsA, tsB;
    __device__ __forceinline__ void map(int wgid, int& pm, int& pn) const {
        { const int q = nwg / NXCD, r = nwg % NXCD, xcd = wgid % NXCD, off = wgid / NXCD; wgid = (xcd < r ? xcd * (q + 1) : r * (q + 1) + (xcd - r) * q) + off; }
        const int nig = WGM * nN, gid = wgid / nig, fm = gid * WGM, gsz = (nM - fm) < WGM ? (nM - fm) : WGM;
        pm = fm + ((wgid % nig) % gsz); pn = (wgid % nig) / gsz;
    }
    __device__ __forceinline__ bool next(int i, Unit& u) const {
        if (kind == 2) {
            const long L = (long)(i >> 1) * G + c; if (L >= nwg) return false;
            int pm, pn; map((int)L, pm, pn); u.pm = pm; u.pn = pn; u.aux = i & 1; u.pad = 0;
            u.A = ((i & 1) ? A2 : A) + (size_t)pm * tsA; u.B = ((i & 1) ? B2 : B) + (size_t)pn * tsB; return true;
        }
        const long L = (long)i * G + c; if (L >= nwg) return false;
        int pm, pn; map((int)L, pm, pn); u.pm = pm; u.pn = pn; u.aux = 0; u.pad = 0;
        u.A = A + (size_t)pm * tsA;
        if (kind == 1) { const int seg = pn >> 2; const int rows = (seg < 5 ? seg * 1024 : 8192 + (seg - 5) * 1024) + (pn & 3) * 256; u.B = B + (size_t)rows * (D * 2); }
        else u.B = B + (size_t)pn * tsB;
        return true;
    }
};

template <class Epi, bool ALIGN_EPI = true, bool SP2 = true>
__device__ __forceinline__ void gemm_phase(LAS unsigned char* lds, const Gemm g, const Sched& S, const Epi& E) {
    const int tid = threadIdx.x, wid = __builtin_amdgcn_readfirstlane(tid >> 6), lane = tid & 63, wr = wid >> 2, wc = wid & 3, fr = lane & 15, fq = lane >> 4;
    const int K = g.K, nt = K / BK;
    unsigned voffA[2], voffB[2];
#pragma unroll
    for (int i = 0; i < 2; ++i) { int R, C; stage_rc(tid * 16 + i * 8192, R, C); const int Rb = (R & ~31) + perm32(R & 31);
        voffA[i] = (unsigned)(R * K + C) * 2u; voffB[i] = (unsigned)(Rb * K + C) * 2u; }
    const size_t kstep = (size_t)(BK * 2);
    const size_t hsA = g.hstepA, hsB = g.hstepB;
    const unsigned ldsw = (unsigned)wid * 1024u;
    const int aoff = lds_byte(wr * 64 + fr, fq * 8), boff = lds_byte(wc * 32 + fr, fq * 8);
#define PG8_SA(b, h) (((b) * 2 + (h)) * HTB)
#define PG8_SB(b, h) ((4 + (b) * 2 + (h)) * HTB)
#define PG8_STAGE(bufoff, gbase, voff) do { _Pragma("unroll") for (int _i = 0; _i < 2; ++_i) \
        __builtin_amdgcn_global_load_lds((const unsigned*)((const char*)(gbase) + (voff)[_i]), (LAS unsigned*)(lds + (bufoff) + ldsw + _i * 8192), 16, 0, 0); } while (0)
#define PG8_LDA(dst, b, h) do { _Pragma("unroll") for (int m = 0; m < 4; ++m) _Pragma("unroll") for (int k = 0; k < 2; ++k) dst[m][k] = *(const LAS bf16x8*)(lds + PG8_SA(b, h) + aoff + m * 2048 + k * 1024); } while (0)
#define PG8_LDB(dst, b, h) do { _Pragma("unroll") for (int n = 0; n < 2; ++n) _Pragma("unroll") for (int k = 0; k < 2; ++k) dst[n][k] = *(const LAS bf16x8*)(lds + PG8_SB(b, h) + boff + n * 2048 + k * 1024); } while (0)
#define PG8_MMA(ai, bj, At, Bt) do { __builtin_amdgcn_s_setprio(1); _Pragma("unroll") for (int m = 0; m < 4; ++m) _Pragma("unroll") for (int n = 0; n < 2; ++n) _Pragma("unroll") for (int k = 0; k < 2; ++k) \
        acc[ai][bj][m][n] = __builtin_amdgcn_mfma_f32_16x16x32_bf16(Bt[n][k], At[m][k], acc[ai][bj][m][n], 0, 0, 0); __builtin_amdgcn_s_setprio(0); } while (0)
#define PG8_WAIT_V(n) asm volatile("s_waitcnt vmcnt(" #n ")" ::: "memory")
#define PG8_WAIT_L(n) asm volatile("s_waitcnt lgkmcnt(" #n ")" ::: "memory")
#define PG8_BAR __builtin_amdgcn_s_barrier()
#define PG8_SCHED __builtin_amdgcn_sched_barrier(0)
    Unit cur, nxt; int ui = 0;
    if (!S.next(0, cur)) return;
    f32x4 acc[2][2][4][2];
#pragma unroll
    for (int a = 0; a < 2; ++a)
#pragma unroll
        for (int b = 0; b < 2; ++b)
#pragma unroll
            for (int m = 0; m < 4; ++m)
#pragma unroll
                for (int n = 0; n < 2; ++n) acc[a][b][m][n] = (f32x4){0.f, 0.f, 0.f, 0.f};
    bf16x8 At[4][2], B0[2][2], B1[2][2];
    const char* cA = cur.A; const char* cB = cur.B;
    if constexpr (SP2) {
        PG8_STAGE(PG8_SB(0, 0), cB, voffB); PG8_STAGE(PG8_SB(0, 1), cB + hsB, voffB); PG8_STAGE(PG8_SA(0, 0), cA, voffA); PG8_STAGE(PG8_SA(0, 1), cA + hsA, voffA);
        if (wr == 1) PG8_BAR;
        PG8_WAIT_V(2); PG8_BAR;
        PG8_STAGE(PG8_SB(1, 0), cB + kstep, voffB); PG8_STAGE(PG8_SA(1, 0), cA + kstep, voffA); PG8_STAGE(PG8_SB(1, 1), cB + hsB + kstep, voffB);
        PG8_WAIT_V(6); PG8_BAR;
    } else {
        PG8_STAGE(PG8_SB(0, 0), cB, voffB); PG8_STAGE(PG8_SA(0, 0), cA, voffA); PG8_STAGE(PG8_SB(0, 1), cB + hsB, voffB); PG8_STAGE(PG8_SA(0, 1), cA + hsA, voffA);
        if (wr == 1) PG8_BAR;
        PG8_WAIT_V(4); PG8_BAR;
        PG8_STAGE(PG8_SB(1, 0), cB + kstep, voffB); PG8_STAGE(PG8_SA(1, 0), cA + kstep, voffA); PG8_STAGE(PG8_SB(1, 1), cB + hsB + kstep, voffB);
        PG8_WAIT_V(6); PG8_BAR;
    }
    for (;;) {
        const bool has_next = S.next(ui + 1, nxt);
        const char* nA = has_next ? nxt.A : cA; const char* nB = has_next ? nxt.B : cB;
        for (int t = 0; t < nt; t += 2) {
            const bool last = (t == nt - 2);
            const char* a1 = cA + (size_t)(t + 1) * kstep;
            const char* a2 = last ? nA : cA + (size_t)(t + 2) * kstep; const char* b2 = last ? nB : cB + (size_t)(t + 2) * kstep;
            const char* a3 = a2 + kstep; const char* b3 = b2 + kstep;
            if constexpr (SP2) {
            PG8_LDB(B0, 0, 0); PG8_LDB(B1, 0, 1); PG8_SCHED; PG8_LDA(At, 0, 0); PG8_STAGE(PG8_SA(1, 1), a1 + hsA, voffA);
            PG8_WAIT_V(8); PG8_WAIT_L(0); PG8_BAR; PG8_MMA(0, 0, At, B0); PG8_MMA(0, 1, At, B1); PG8_BAR; PG8_SCHED;
            PG8_LDA(At, 0, 1); PG8_STAGE(PG8_SB(0, 0), b2, voffB); PG8_STAGE(PG8_SB(0, 1), b2 + hsB, voffB); PG8_STAGE(PG8_SA(0, 0), a2, voffA);
            PG8_WAIT_V(8); PG8_WAIT_L(0); PG8_BAR; PG8_MMA(1, 0, At, B0); PG8_MMA(1, 1, At, B1); PG8_BAR; PG8_SCHED;
            PG8_LDB(B0, 1, 0); PG8_LDB(B1, 1, 1); PG8_SCHED; PG8_LDA(At, 1, 0); PG8_STAGE(PG8_SA(0, 1), a2 + hsA, voffA);
            PG8_WAIT_V(8); PG8_WAIT_L(0); PG8_BAR; PG8_MMA(0, 0, At, B0); PG8_MMA(0, 1, At, B1); PG8_BAR; PG8_SCHED;
            PG8_LDA(At, 1, 1); PG8_STAGE(PG8_SB(1, 0), b3, voffB); PG8_STAGE(PG8_SB(1, 1), b3 + hsB, voffB); PG8_STAGE(PG8_SA(1, 0), a3, voffA);
            PG8_WAIT_V(8); PG8_WAIT_L(0); PG8_BAR; PG8_MMA(1, 0, At, B0); PG8_MMA(1, 1, At, B1); PG8_BAR; PG8_SCHED;
            } else {
            PG8_LDB(B0, 0, 0); PG8_SCHED; PG8_LDA(At, 0, 0); PG8_STAGE(PG8_SA(1, 1), a1 + hsA, voffA);
            PG8_WAIT_L(8); PG8_BAR; PG8_WAIT_L(0); PG8_MMA(0, 0, At, B0); PG8_BAR; PG8_SCHED;
            PG8_LDB(B1, 0, 1); PG8_STAGE(PG8_SB(0, 0), b2, voffB);
            PG8_BAR; PG8_WAIT_L(0); PG8_MMA(0, 1, At, B1); PG8_BAR;
            PG8_LDA(At, 0, 1); PG8_STAGE(PG8_SA(0, 0), a2, voffA);
            PG8_BAR; PG8_WAIT_L(0); PG8_MMA(1, 0, At, B0); PG8_BAR; PG8_SCHED;
            PG8_STAGE(PG8_SB(0, 1), b2 + hsB, voffB);
            PG8_WAIT_V(6); PG8_BAR; PG8_MMA(1, 1, At, B1); PG8_BAR;
            PG8_LDB(B0, 1, 0); PG8_SCHED; PG8_LDA(At, 1, 0); PG8_STAGE(PG8_SA(0, 1), a2 + hsA, voffA);
            PG8_WAIT_L(8); PG8_BAR; PG8_WAIT_L(0); PG8_MMA(0, 0, At, B0); PG8_BAR; PG8_SCHED;
            PG8_LDB(B1, 1, 1); PG8_STAGE(PG8_SB(1, 0), b3, voffB);
            PG8_BAR; PG8_WAIT_L(0); PG8_MMA(0, 1, At, B1); PG8_BAR;
            PG8_LDA(At, 1, 1); PG8_STAGE(PG8_SA(1, 0), a3, voffA);
            PG8_BAR; PG8_WAIT_L(0); PG8_MMA(1, 0, At, B0); PG8_BAR; PG8_SCHED;
            PG8_STAGE(PG8_SB(1, 1), b3 + hsB, voffB);
            PG8_WAIT_V(6); PG8_BAR; PG8_MMA(1, 1, At, B1); PG8_BAR;
            }
        }
        if constexpr (ALIGN_EPI) { if (wr == 0) PG8_BAR; }
        E(acc, cur, wr, wc, fr, fq);
        if (!has_next) break;
        if (!E.keep(cur)) {
#pragma unroll
            for (int a = 0; a < 2; ++a)
#pragma unroll
                for (int b = 0; b < 2; ++b)
#pragma unroll
                    for (int m = 0; m < 4; ++m)
#pragma unroll
                        for (int n = 0; n < 2; ++n) acc[a][b][m][n] = (f32x4){0.f, 0.f, 0.f, 0.f};
        }
        cur = nxt; cA = nA; cB = nB; ++ui;
        if constexpr (ALIGN_EPI) { if (wr == 1) PG8_BAR; }
    }
    PG8_WAIT_V(0);
    if constexpr (!ALIGN_EPI) { if (wr == 0) PG8_BAR; }
    PG8_BAR;
#undef PG8_SA
#undef PG8_SB
#undef PG8_STAGE
#undef PG8_LDA
#undef PG8_LDB
#undef PG8_MMA
#undef PG8_WAIT_V
#undef PG8_WAIT_L
#undef PG8_BAR
#undef PG8_SCHED
}
}

typedef f32x4 AccT[2][2][4][2];

struct EpiIn {
    u16* out[7]; const float* LB;
    __device__ __forceinline__ bool keep(const pg8::Unit&) const { return false; }
    template <int ACT> __device__ __forceinline__ void run(AccT& acc, const pg8::Unit& u, int wr, int wc, int fr, int fq, u16* O, const float* lbp) const {
        const int row0 = u.pm * 256 + wr * 64 + fr, colb = (u.pn & 3) * 256 + wc * 32 + 8 * fq;
#pragma unroll
        for (int bj = 0; bj < 2; ++bj) {
            const int col = colb + bj * 128;
            float lbv[8];
            if (ACT == 2) { const f32x4 l0 = *(const f32x4*)(lbp + col), l1 = *(const f32x4*)(lbp + col + 4);
                lbv[0] = l0[0]; lbv[1] = l0[1]; lbv[2] = l0[2]; lbv[3] = l0[3]; lbv[4] = l1[0]; lbv[5] = l1[1]; lbv[6] = l1[2]; lbv[7] = l1[3]; }
#pragma unroll
            for (int ai = 0; ai < 2; ++ai)
#pragma unroll
                for (int m = 0; m < 4; ++m) {
                    const int row = row0 + ai * 128 + m * 16;
                    float v[8];
#pragma unroll
                    for (int e = 0; e < 4; ++e) { v[e] = acc[ai][bj][m][0][e]; v[4 + e] = acc[ai][bj][m][1][e]; }
                    u32x4 w;
                    if (ACT == 2) {
                        unsigned ww[4];
#pragma unroll
                        for (int e = 0; e < 4; ++e) {
                            const float f0 = lbv[2 * e] + (1.f - lbv[2 * e]) * sigmoid_f(v[2 * e]);
                            const float f1 = lbv[2 * e + 1] + (1.f - lbv[2 * e + 1]) * sigmoid_f(v[2 * e + 1]);
                            h16x2 hp; hp.x = (_Float16)__logf(f0); hp.y = (_Float16)__logf(f1);
                            ww[e] = __builtin_bit_cast(unsigned, hp);
                        }
                        w.x = ww[0]; w.y = ww[1]; w.z = ww[2]; w.w = ww[3];
                    } else {
#pragma unroll
                        for (int e = 0; e < 8; ++e) { if (ACT == 1) v[e] = silu_f(v[e]); if (ACT == 3) v[e] = sigmoid_f(v[e]); }
                        w.x = cvt_pk_bf16(v[0], v[1]); w.y = cvt_pk_bf16(v[2], v[3]); w.z = cvt_pk_bf16(v[4], v[5]); w.w = cvt_pk_bf16(v[6], v[7]);
                    }
                    *(u32x4*)(O + (size_t)row * D + col) = w;
                }
        }
    }
    __device__ __forceinline__ void operator()(AccT& acc, const pg8::Unit& u, int wr, int wc, int fr, int fq) const {
        const int seg = u.pn >> 2; u16* O = seg == 0 ? out[0] : seg == 1 ? out[1] : seg == 2 ? out[2] : seg == 3 ? out[3] : seg == 4 ? out[4] : seg == 5 ? out[5] : out[6];
        if (seg == 0 || seg == 4) run<1>(acc, u, wr, wc, fr, fq, O, LB);
        else if (seg == 1 || seg == 2) run<2>(acc, u, wr, wc, fr, fq, O, LB + (seg - 1) * 1024);
        else if (seg == 3) run<0>(acc, u, wr, wc, fr, fq, O, LB);
        else run<3>(acc, u, wr, wc, fr, fq, O, LB);
    }
};
struct EpiBf {
    u16* O; int ld;
    __device__ __forceinline__ bool keep(const pg8::Unit&) const { return false; }
    __device__ __forceinline__ void operator()(AccT& acc, const pg8::Unit& u, int wr, int wc, int fr, int fq) const {
        const int row0 = u.pm * 256 + wr * 64 + fr, colb = u.pn * 256 + wc * 32 + 8 * fq;
#pragma unroll
        for (int ai = 0; ai < 2; ++ai)
#pragma unroll
            for (int m = 0; m < 4; ++m)
#pragma unroll
                for (int bj = 0; bj < 2; ++bj) {
                    const f32x4 v0 = acc[ai][bj][m][0], v1 = acc[ai][bj][m][1];
                    u32x4 w; w.x = cvt_pk_bf16(v0[0], v0[1]); w.y = cvt_pk_bf16(v0[2], v0[3]); w.z = cvt_pk_bf16(v1[0], v1[1]); w.w = cvt_pk_bf16(v1[2], v1[3]);
                    *(u32x4*)(O + (size_t)(row0 + ai * 128 + m * 16) * ld + colb + bj * 128) = w;
                }
    }
};
struct EpiMerge {
    const u16* GA; const u16* GB; u16* T1;
    __device__ __forceinline__ bool keep(const pg8::Unit& u) const { return u.aux == 0; }
    __device__ __forceinline__ void operator()(AccT& acc, const pg8::Unit& u, int wr, int wc, int fr, int fq) const {
        const int row0 = u.pm * 256 + wr * 64 + fr, colb = u.pn * 256 + wc * 32 + 8 * fq;
#pragma unroll
        for (int ai = 0; ai < 2; ++ai)
#pragma unroll
            for (int m = 0; m < 4; ++m)
#pragma unroll
                for (int bj = 0; bj < 2; ++bj) {
                    const size_t idx = (size_t)(row0 + ai * 128 + m * 16) * D + colb + bj * 128;
                    const u32x4 gb = *(const u32x4*)(GB + idx);
                    float b[8] = {bflo(gb.x), bfhi(gb.x), bflo(gb.y), bfhi(gb.y), bflo(gb.z), bfhi(gb.z), bflo(gb.w), bfhi(gb.w)};
                    if (u.aux == 0) {
                        const u32x4 ga = *(const u32x4*)(GA + idx);
                        float a[8] = {bflo(ga.x), bfhi(ga.x), bflo(ga.y), bfhi(ga.y), bflo(ga.z), bfhi(ga.z), bflo(ga.w), bfhi(ga.w)};
#pragma unroll
                        for (int e = 0; e < 4; ++e) { acc[ai][bj][m][0][e] *= a[e] * __builtin_amdgcn_rcpf(fmaxf(b[e], 1e-30f)); acc[ai][bj][m][1][e] *= a[4 + e] * __builtin_amdgcn_rcpf(fmaxf(b[4 + e], 1e-30f)); }
                    } else {
                        const f32x4 v0 = acc[ai][bj][m][0], v1 = acc[ai][bj][m][1];
                        u32x4 w; w.x = cvt_pk_bf16(v0[0] * b[0], v0[1] * b[1]); w.y = cvt_pk_bf16(v0[2] * b[2], v0[3] * b[3]);
                        w.z = cvt_pk_bf16(v1[0] * b[4], v1[1] * b[5]); w.w = cvt_pk_bf16(v1[2] * b[6], v1[3] * b[7]);
                        *(u32x4*)(T1 + idx) = w;
                    }
                }
    }
};
template <bool RBF>
struct EpiRes {
    const void* R0; const void* R1; const float* gate; u16* O;
    __device__ __forceinline__ bool keep(const pg8::Unit&) const { return false; }
    __device__ __forceinline__ void operator()(AccT& acc, const pg8::Unit& u, int wr, int wc, int fr, int fq) const {
        const int row0 = u.pm * 256 + wr * 64 + fr, colb = u.pn * 256 + wc * 32 + 8 * fq;
        const float* gp = gate + (size_t)cid_of(u.pm * 256) * NMOD;
#pragma unroll
        for (int bj = 0; bj < 2; ++bj) {
            const int col = colb + bj * 128;
            const f32x4 g0 = *(const f32x4*)(gp + col), g1 = *(const f32x4*)(gp + col + 4);
#pragma unroll
            for (int ai = 0; ai < 2; ++ai)
#pragma unroll
                for (int m = 0; m < 4; ++m) {
                    const int row = row0 + ai * 128 + m * 16;
                    float x[8];
                    if (RBF) {
                        const u32x4 xr = *(const u32x4*)((const u16*)R0 + (size_t)row * D + col);
                        x[0] = bflo(xr.x); x[1] = bfhi(xr.x); x[2] = bflo(xr.y); x[3] = bfhi(xr.y); x[4] = bflo(xr.z); x[5] = bfhi(xr.z); x[6] = bflo(xr.w); x[7] = bfhi(xr.w);
                    } else {
                        const float* rp = (row < 8192 ? (const float*)R0 + (size_t)row * D : (const float*)R1 + (size_t)(row - 8192) * D) + col;
                        const f32x4 x0 = *(const f32x4*)rp, x1 = *(const f32x4*)(rp + 4);
                        x[0] = x0[0]; x[1] = x0[1]; x[2] = x0[2]; x[3] = x0[3]; x[4] = x1[0]; x[5] = x1[1]; x[6] = x1[2]; x[7] = x1[3];
                    }
                    float o[8];
#pragma unroll
                    for (int e = 0; e < 4; ++e) { o[e] = ALPHA * x[e] + g0[e] * acc[ai][bj][m][0][e]; o[4 + e] = ALPHA * x[4 + e] + g1[e] * acc[ai][bj][m][1][e]; }
                    u32x4 w; w.x = cvt_pk_bf16(o[0], o[1]); w.y = cvt_pk_bf16(o[2], o[3]); w.z = cvt_pk_bf16(o[4], o[5]); w.w = cvt_pk_bf16(o[6], o[7]);
                    *(u32x4*)(O + (size_t)row * D + col) = w;
                }
        }
    }
};
struct EpiGlu {
    u16* FF;
    __device__ __forceinline__ bool keep(const pg8::Unit&) const { return false; }
    __device__ __forceinline__ void operator()(AccT& acc, const pg8::Unit& u, int wr, int wc, int fr, int fq) const {
        const int row0 = u.pm * 256 + wr * 64 + fr, col = u.pn * 128 + wc * 32 + 8 * fq;
#pragma unroll
        for (int ai = 0; ai < 2; ++ai)
#pragma unroll
            for (int m = 0; m < 4; ++m) {
                float v[8];
#pragma unroll
                for (int e = 0; e < 4; ++e) { v[e] = silu_f(acc[ai][0][m][0][e]) * acc[ai][1][m][0][e]; v[4 + e] = silu_f(acc[ai][0][m][1][e]) * acc[ai][1][m][1][e]; }
                u32x4 w; w.x = cvt_pk_bf16(v[0], v[1]); w.y = cvt_pk_bf16(v[2], v[3]); w.z = cvt_pk_bf16(v[4], v[5]); w.w = cvt_pk_bf16(v[6], v[7]);
                *(u32x4*)(FF + (size_t)(row0 + ai * 128 + m * 16) * DFF + col) = w;
            }
    }
};

__device__ __forceinline__ void convert_tile4(LAS unsigned char* lds, const float* W, u16* WT, int K, int N, int su) {
    LAS float* tl = (LAS float*)lds;
    const int tiles_n = N >> 8, tk = su / tiles_n, tn = su - tk * tiles_n, k0 = tk * 64, n0 = tn * 256, tid = threadIdx.x;
    {
        const int kr = tid >> 6, nc = (tid & 63) * 4;
        f32x4 v[8];
#pragma unroll
        for (int it = 0; it < 8; ++it) v[it] = *(const f32x4*)(W + (size_t)(k0 + kr + 8 * it) * N + n0 + nc);
#pragma unroll
        for (int it = 0; it < 8; ++it) { LAS float* d = tl + (kr + 8 * it) * 257 + nc; d[0] = v[it][0]; d[1] = v[it][1]; d[2] = v[it][2]; d[3] = v[it][3]; }
    }
    __syncthreads();
    {
        const int nr = tid >> 1, kc = (tid & 1) * 32;
#pragma unroll
        for (int q = 0; q < 4; ++q) {
            float v[8];
#pragma unroll
            for (int e = 0; e < 8; ++e) v[e] = tl[(kc + 8 * q + e) * 257 + nr];
            u32x4 w; w.x = cvt_pk_bf16(v[0], v[1]); w.y = cvt_pk_bf16(v[2], v[3]); w.z = cvt_pk_bf16(v[4], v[5]); w.w = cvt_pk_bf16(v[6], v[7]);
            *(u32x4*)(WT + (size_t)(n0 + nr) * K + k0 + kc + 8 * q) = w;
        }
    }
    __syncthreads();
}

__device__ __forceinline__ void phase_prep(LAS unsigned char* lds, const Ctx& C) {
    const int tid = threadIdx.x;
    u16* WIN = (u16*)(C.ws + WS_WIN); u16* WPA = (u16*)(C.ws + WS_WPA); u16* WPB = (u16*)(C.ws + WS_WPB); u16* WOUT = (u16*)(C.ws + WS_WOUT);
    float* MOD = (float*)(C.ws + WS_MOD); float* LB = (float*)(C.ws + WS_LB);
    constexpr int N_CV = 640 + 64 * 3, N_MODU = 192, N_H3 = 272, N_ALL = N_CV + N_MODU + N_H3 + 1;
    for (int u = blockIdx.x; u < N_ALL; u += gridDim.x) {
        if (u < N_CV) {
            if (u < 640) convert_tile4(lds, C.in[7], WIN, 1024, NIN, u);
            else if (u < 704) convert_tile4(lds, C.in[21], WPA, 1024, 1024, u - 640);
            else if (u < 768) convert_tile4(lds, C.in[22], WPB, 1024, 1024, u - 704);
            else convert_tile4(lds, C.in[23], WOUT, 1024, 1024, u - 768);
        } else if (u < N_CV + N_MODU) {
            const int mu = u - N_CV, n0 = mu * 32, col = tid & 31, ks = tid >> 5;
            const float* cctx = C.in[4]; const float* cc = C.in[3]; const float* aw = C.in[5];
            LAS float* sc = (LAS float*)lds;
            LAS float* red = (LAS float*)(lds + 12288);
            for (int i = tid; i < 3072; i += 512) sc[i] = silu_f(i < 1024 ? cctx[i] : cc[i - 1024]);
            __syncthreads();
            float a0 = 0.f, a1 = 0.f, a2 = 0.f;
#pragma unroll
            for (int kb = 0; kb < 64; kb += 16) {
                float w[16];
#pragma unroll
                for (int kk = 0; kk < 16; ++kk) w[kk] = aw[(size_t)(ks * 64 + kb + kk) * NMOD + n0 + col];
#pragma unroll
                for (int kk = 0; kk < 16; ++kk) { const int k = ks * 64 + kb + kk; a0 += sc[k] * w[kk]; a1 += sc[1024 + k] * w[kk]; a2 += sc[2048 + k] * w[kk]; }
            }
            red[(0 * 16 + ks) * 32 + col] = a0; red[(1 * 16 + ks) * 32 + col] = a1; red[(2 * 16 + ks) * 32 + col] = a2;
            __syncthreads();
            if (tid < 96) { const int ci = tid >> 5, c2 = tid & 31; float s2 = C.in[6][n0 + c2];
#pragma unroll
                for (int k = 0; k < 16; ++k) s2 += red[(ci * 16 + k) * 32 + c2];
                MOD[ci * NMOD + n0 + c2] = s2; }
            __syncthreads();
        } else if (u < N_CV + N_MODU + N_H3) {
            const int hu = u - N_CV - N_MODU, pl = tid >> 6, j = tid & 63;
            LAS float* zs = (LAS float*)lds;
            LAS float* h1 = (LAS float*)(lds + 4096);
            LAS float* h2 = (LAS float*)(lds + 8192);
            u16* Hhi[2]; u16* Hlo[2];
#pragma unroll
            for (int pp = 0; pp < 2; ++pp) {
                const int pos = hu * 16 + pl + 8 * pp;
                const int L = pos < 256 ? 256 : 4096, t = pos < 256 ? pos : pos - 256;
                Hhi[pp] = pos < 256 ? (u16*)(C.ws + WS_H3P) + (size_t)t * 64 : (u16*)(C.ws + WS_H3S) + (size_t)t * 64;
                Hlo[pp] = Hhi[pp] + (pos < 256 ? 256 * 64 : 4096 * 64);
                if (j < 33) {
                    float z;
                    if (j == 0) z = (float)t / (float)(L - 1);
                    else {
                        const int bnd = (j - 1) & 15;
                        const float band = 1e-4f + (float)bnd * ((15.0f - 1e-4f) / 15.0f);
                        const float wpos = (float)(6.283185307179586 / (double)L) * (float)t;
                        const float ang = band * wpos;
                        z = (j <= 16) ? my_cos(ang) : -my_sin(ang);
                    }
                    zs[(pl + 8 * pp) * 40 + j] = z;
                }
            }
            __syncthreads();
            const float* fq = C.in[18];
            { float s0 = C.in[13][j], s1 = s0; const float* w1 = C.in[12];
#pragma unroll 11
              for (int i = 0; i < 33; ++i) { const float w = w1[i * 64 + j]; s0 += zs[pl * 40 + i] * w; s1 += zs[(pl + 8) * 40 + i] * w; }
              h1[pl * 64 + j] = my_sin(fq[j] * s0); h1[(pl + 8) * 64 + j] = my_sin(fq[j] * s1); }
            __syncthreads();
            { float s0 = C.in[15][j], s1 = s0; const float* w2 = C.in[14];
#pragma unroll 32
              for (int i = 0; i < 64; ++i) { const float w = w2[i * 64 + j]; s0 += h1[pl * 64 + i] * w; s1 += h1[(pl + 8) * 64 + i] * w; }
              h2[pl * 64 + j] = my_sin(fq[64 + j] * s0); h2[(pl + 8) * 64 + j] = my_sin(fq[64 + j] * s1); }
            __syncthreads();
            { float s0 = C.in[17][j], s1 = s0; const float* w3 = C.in[16];
#pragma unroll 32
              for (int i = 0; i < 64; ++i) { const float w = w3[i * 64 + j]; s0 += h2[pl * 64 + i] * w; s1 += h2[(pl + 8) * 64 + i] * w; }
              const float hv0 = my_sin(fq[128 + j] * s0), hv1 = my_sin(fq[128 + j] * s1);
              const u16 hb0 = f2bf(hv0), hb1 = f2bf(hv1);
              Hhi[0][j] = hb0; Hlo[0][j] = f2bf(hv0 - bf2f(hb0)); Hhi[1][j] = hb1; Hlo[1][j] = f2bf(hv1 - bf2f(hb1)); }
            __syncthreads();
        } else {
            const float* lg = C.in[8];
            for (int i = tid; i < 2048; i += 512) LB[i] = 1.f / (1.f + expf(lg[2048 + i] - lg[i]));
        }
    }
}

__device__ __forceinline__ void phase_modulate(const Ctx& C) {
    const int tid = threadIdx.x, c4 = (tid & 255) * 4, r2 = tid >> 8;
    const float* MOD = (const float*)(C.ws + WS_MOD); u16* HB = (u16*)(C.ws + WS_HB);
    for (int ch = blockIdx.x; ch < T / 64; ch += gridDim.x) {
        const int tok0 = ch * 64; const float* mp = MOD + (size_t)cid_of(tok0) * NMOD;
        const f32x4 sh = *(const f32x4*)(mp + c4); f32x4 sc = *(const f32x4*)(mp + 1024 + c4);
#pragma unroll
        for (int e = 0; e < 4; ++e) sc[e] += 1.f;
#pragma unroll
        for (int hb = 0; hb < 2; ++hb) {
            f32x4 a[16];
#pragma unroll
            for (int it = 0; it < 16; ++it) a[it] = *(const f32x4*)(C.xrow(tok0 + r2 + 2 * (16 * hb + it)) + c4);
#pragma unroll
            for (int it = 0; it < 16; ++it) {
                const int tok = tok0 + r2 + 2 * (16 * hb + it);
                u32x2 w; w.x = cvt_pk_bf16(a[it][0] * sc[0] + sh[0], a[it][1] * sc[1] + sh[1]); w.y = cvt_pk_bf16(a[it][2] * sc[2] + sh[2], a[it][3] * sc[3] + sh[3]);
                *(u32x2*)(HB + (size_t)tok * D + c4) = w;
            }
        }
    }
}

__device__ __forceinline__ float wave_sum(float v) {
#pragma unroll
    for (int o = 32; o >= 1; o >>= 1) v += __shfl_xor(v, o, 64);
    return v;
}
template <bool WITH_H>
__device__ __forceinline__ void phase_ln(const Ctx& C, const u16* U, float* Y, u16* Y16, const float* gam, const float* bet, u16* H, int scale_idx, int shift_idx) {
    const int lane = threadIdx.x & 63, wv = threadIdx.x >> 6;
    const float* MOD = (const float*)(C.ws + WS_MOD);
    for (int row0 = (blockIdx.x * 8 + wv) * 4; row0 < T; row0 += gridDim.x * 32) {
        u32x4 raw[4][2];
#pragma unroll
        for (int rr = 0; rr < 4; ++rr)
#pragma unroll
            for (int i = 0; i < 2; ++i) raw[rr][i] = *(const u32x4*)(U + (size_t)(row0 + rr) * D + 8 * lane + 512 * i);
        const float* mp = MOD + (size_t)cid_of(row0) * NMOD;
#pragma unroll
        for (int rr = 0; rr < 4; ++rr) {
            const int row = row0 + rr;
            float v[2][8];
#pragma unroll
            for (int i = 0; i < 2; ++i) { const u32x4 r = raw[rr][i];
                v[i][0] = bflo(r.x); v[i][1] = bfhi(r.x); v[i][2] = bflo(r.y); v[i][3] = bfhi(r.y); v[i][4] = bflo(r.z); v[i][5] = bfhi(r.z); v[i][6] = bflo(r.w); v[i][7] = bfhi(r.w); }
            float s = 0.f;
#pragma unroll
            for (int i = 0; i < 2; ++i)
#pragma unroll
                for (int e = 0; e < 8; ++e) s += v[i][e];
            const float mu = wave_sum(s) * (1.f / 1024.f);
            float q = 0.f;
#pragma unroll
            for (int i = 0; i < 2; ++i)
#pragma unroll
                for (int e = 0; e < 8; ++e) { const float d = v[i][e] - mu; q += d * d; }
            const float rstd = rsqrtf(wave_sum(q) * (1.f / 1024.f) + 1e-5f);
#pragma unroll
            for (int i = 0; i < 2; ++i) {
                const int col = 8 * lane + 512 * i;
                const f32x4 g0 = *(const f32x4*)(gam + col), g1 = *(const f32x4*)(gam + col + 4), b0 = *(const f32x4*)(bet + col), b1 = *(const f32x4*)(bet + col + 4);
                float y[8];
#pragma unroll
                for (int e = 0; e < 4; ++e) { y[e] = (v[i][e] - mu) * rstd * g0[e] + b0[e]; y[4 + e] = (v[i][4 + e] - mu) * rstd * g1[e] + b1[e]; }
                if (WITH_H) {
                    u32x4 w; w.x = cvt_pk_bf16(y[0], y[1]); w.y = cvt_pk_bf16(y[2], y[3]); w.z = cvt_pk_bf16(y[4], y[5]); w.w = cvt_pk_bf16(y[6], y[7]);
                    *(u32x4*)(Y16 + (size_t)row * D + col) = w;
                    const f32x4 sc0 = *(const f32x4*)(mp + scale_idx * 1024 + col), sc1 = *(const f32x4*)(mp + scale_idx * 1024 + col + 4);
                    const f32x4 sh0 = *(const f32x4*)(mp + shift_idx * 1024 + col), sh1 = *(const f32x4*)(mp + shift_idx * 1024 + col + 4);
                    float hv[8];
#pragma unroll
                    for (int e = 0; e < 4; ++e) { hv[e] = y[e] * (1.f + sc0[e]) + sh0[e]; hv[4 + e] = y[4 + e] * (1.f + sc1[e]) + sh1[e]; }
                    w.x = cvt_pk_bf16(hv[0], hv[1]); w.y = cvt_pk_bf16(hv[2], hv[3]); w.z = cvt_pk_bf16(hv[4], hv[5]); w.w = cvt_pk_bf16(hv[6], hv[7]);
                    *(u32x4*)(H + (size_t)row * D + col) = w;
                } else {
                    float* yp = Y + (size_t)row * D + col;
                    *(f32x4*)yp = (f32x4){y[0], y[1], y[2], y[3]}; *(f32x4*)(yp + 4) = (f32x4){y[4], y[5], y[6], y[7]};
                }
            }
        }
    }
}

__device__ __forceinline__ void short_conv8(const u16* row, int p0, int RL, float w0, float w1, float w2, float bias, float* out) {
    const u32x4 raw = *(const u32x4*)(row + p0);
    float u[10];
    u[1] = bflo(raw.x); u[2] = bfhi(raw.x); u[3] = bflo(raw.y); u[4] = bfhi(raw.y); u[5] = bflo(raw.z); u[6] = bfhi(raw.z); u[7] = bflo(raw.w); u[8] = bfhi(raw.w);
    u[0] = (p0 & (RL - 1)) != 0 ? bf2f(row[p0 - 1]) : 0.f;
    u[9] = ((p0 + 8) & (RL - 1)) != 0 ? bf2f(row[p0 + 8]) : 0.f;
#pragma unroll
    for (int e = 0; e < 8; ++e) out[e] = w0 * u[e] + w1 * u[e + 1] + w2 * u[e + 2] + bias;
}
__device__ __forceinline__ int zswz(int p8) { return 80 * (p8 >> 2) + 16 * (p8 & 3); }

struct ToepRaw { unsigned w0, w1, w2, w3, w4; };
__device__ __forceinline__ ToepRaw toep_load(const LAS unsigned* FRw, int mb) {
    const int dw = mb >> 1; ToepRaw r; r.w0 = FRw[dw]; r.w1 = FRw[dw + 1]; r.w2 = FRw[dw + 2]; r.w3 = FRw[dw + 3]; r.w4 = FRw[dw + 4]; return r;
}
__device__ __forceinline__ bf16x8 toep_align(const ToepRaw& r, unsigned sh) {
    u32x4 o; o.x = __builtin_amdgcn_alignbyte(r.w1, r.w0, sh); o.y = __builtin_amdgcn_alignbyte(r.w2, r.w1, sh); o.z = __builtin_amdgcn_alignbyte(r.w3, r.w2, sh); o.w = __builtin_amdgcn_alignbyte(r.w4, r.w3, sh);
    return __builtin_bit_cast(bf16x8, o);
}
__device__ __forceinline__ int zaddr(int b, int piece) { return 64 * b + 16 * (piece ^ ((b >> 2) & 3)); }
template <int M>
__device__ __forceinline__ void toep_run(f32x16 (&acc)[4], const LAS unsigned* FRw, int mb0, const LAS unsigned char* Zc, int b00, int bstep, int g, int k0, int k1) {
    const unsigned sh = (unsigned)(mb0 & 1) * 2u;
    ToepRaw r0 = toep_load(FRw, mb0 - 32 * k0), r1 = toep_load(FRw, mb0 - 32 * k0 + 16);
    bf16x8 bc[4][2];
#pragma unroll
    for (int j = 0; j < 4; ++j) if ((M >> j) & 1) { const int b = b00 + j * bstep - k0; bc[j][0] = *(const LAS bf16x8*)(Zc + zaddr(b, g)); bc[j][1] = *(const LAS bf16x8*)(Zc + zaddr(b, 2 + g)); }
#pragma unroll 1
    for (int k = k0; k <= k1; ++k) {
        const bf16x8 a0 = toep_align(r0, sh), a1 = toep_align(r1, sh);
        const int kn = k < k1 ? k + 1 : k;
        r0 = toep_load(FRw, mb0 - 32 * kn); r1 = toep_load(FRw, mb0 - 32 * kn + 16);
        bf16x8 bn[4][2];
#pragma unroll
        for (int j = 0; j < 4; ++j) if ((M >> j) & 1) { const int b = b00 + j * bstep - kn; bn[j][0] = *(const LAS bf16x8*)(Zc + zaddr(b, g)); bn[j][1] = *(const LAS bf16x8*)(Zc + zaddr(b, 2 + g)); }
#pragma unroll
        for (int j = 0; j < 4; ++j) if ((M >> j) & 1) acc[j] = mfma32(a0, bc[j][0], acc[j]);
#pragma unroll
        for (int j = 0; j < 4; ++j) if ((M >> j) & 1) acc[j] = mfma32(a1, bc[j][1], acc[j]);
#pragma unroll
        for (int j = 0; j < 4; ++j) if ((M >> j) & 1) { bc[j][0] = bn[j][0]; bc[j][1] = bn[j][1]; }
    }
}

__device__ __forceinline__ void conv_unit(LAS unsigned char* lds, const Ctx& C, int smp, int cgi) {
    const int tid = threadIdx.x, lane = tid & 63, wv = tid >> 6;
    const int L = smp ? 4096 : 256, nb = L >> 5, lnb = smp ? 7 : 3, RL = smp ? 64 : 256, utok0 = smp ? 8192 : 0, d0 = 4 * cgi;
    const int P = smp ? 31 : 7, nblk = smp ? 349 : 487, ZCH = nblk * 64, FRS = 4 * L;
    const u16* H3hi = smp ? (const u16*)(C.ws + WS_H3S) : (const u16*)(C.ws + WS_H3P);
    const u16* H3lo = H3hi + (size_t)L * 64;
    const u16* HYT = (const u16*)(C.ws + WS_R60);
    u16* OB = (u16*)C.out;
    LAS unsigned char* FRb = lds;
    LAS unsigned char* Zb = lds + 4 * FRS;
#define ZPOS(n) (P + ((n) >> lnb) * (nb + P) + ((n) & (nb - 1)))
    {
        const int n = lane & 31, hh = lane >> 5, o = n & 7, c = o & 3;
        const int gcol = (o >> 2) * 1024 + d0 + c;
        bf16x8 Bhi[4], Blo[4];
#pragma unroll
        for (int kk = 0; kk < 4; ++kk) {
            float wv8[8], wl8[8];
#pragma unroll
            for (int e = 0; e < 8; ++e) {
                const float w = (n < 8) ? C.in[19][(size_t)(16 * kk + 8 * hh + e) * 2048 + gcol] : 0.f;
                const float whi = bf2f(f2bf(w)); wv8[e] = whi; wl8[e] = w - whi;
            }
            Bhi[kk] = pack8(wv8[0], wv8[1], wv8[2], wv8[3], wv8[4], wv8[5], wv8[6], wv8[7]);
            Blo[kk] = pack8(wl8[0], wl8[1], wl8[2], wl8[3], wl8[4], wl8[5], wl8[6], wl8[7]);
        }
        const float mind = -3.0701134573253943f, maxd = -15.350567286626972f;
        const float escale = -1.4426950408889634f / (float)(L - 1);
        float delta4[4], skip4[4];
#pragma unroll
        for (int cc = 0; cc < 4; ++cc) { delta4[cc] = fabsf(mind + (maxd - mind) * ((float)(d0 + cc) / 1023.f)); skip4[cc] = C.in[20][d0 + cc]; }
        if (tid < 4) ((LAS u16*)(FRb + tid * FRS))[0] = 0;
        const int nrb = L >> 5;
        const int wvu = __builtin_amdgcn_readfirstlane(wv);
        LAS unsigned char* stg = Zb + wvu * 8192;
        const int goff0 = (lane >> 3) * 128 + 16 * ((lane & 7) ^ ((lane >> 3) & 7));
#define FILT_DMA(rbx) do { const unsigned char* gh_ = (const unsigned char*)H3hi + (size_t)(rbx) * 4096; const unsigned char* gl_ = (const unsigned char*)H3lo + (size_t)(rbx) * 4096; \
        _Pragma("unroll") for (int q = 0; q < 4; ++q) { \
            __builtin_amdgcn_global_load_lds((const unsigned*)(gh_ + goff0 + 1024 * q), (LAS unsigned*)(stg + 1024 * q), 16, 0, 0); \
            __builtin_amdgcn_global_load_lds((const unsigned*)(gl_ + goff0 + 1024 * q), (LAS unsigned*)(stg + 4096 + 1024 * q), 16, 0, 0); } } while (0)
        if (wvu < nrb) FILT_DMA(wvu);
        for (int rb = wvu; rb < nrb; rb += 8) {
            asm volatile("s_waitcnt vmcnt(0)" ::: "memory");
            bf16x8 xh[4], xl[4];
#pragma unroll
            for (int kk = 0; kk < 4; ++kk) { const int off = n * 128 + 16 * ((2 * kk + hh) ^ (n & 7));
                xh[kk] = *(const LAS bf16x8*)(stg + off); xl[kk] = *(const LAS bf16x8*)(stg + 4096 + off); }
            asm volatile("s_waitcnt lgkmcnt(0)" ::: "memory");
            if (rb + 8 < nrb) FILT_DMA(rb + 8);
            f32x16 acc;
#pragma unroll
            for (int e = 0; e < 16; ++e) acc[e] = 0.f;
#pragma unroll
            for (int kk = 0; kk < 4; ++kk) { acc = mfma32(Bhi[kk], xh[kk], acc); acc = mfma32(Bhi[kk], xl[kk], acc); acc = mfma32(Blo[kk], xh[kk], acc); }
            {
                const int tt = 32 * rb + n;
                const float tsc = (float)tt * escale;
#pragma unroll
                for (int cc = 0; cc < 4; ++cc) {
                    const float win = __builtin_amdgcn_exp2f(tsc * delta4[cc]) + 0.05f;
                    float val = acc[cc] * win;
                    LAS u16* frc = (LAS u16*)(FRb + cc * FRS);
                    if (hh == 0) { if (tt == 0) val += skip4[cc]; frc[L - tt] = f2bf(val); }
                    else if (tt > 0) frc[L + tt] = f2bf(val);
                }
            }
        }
    }
#undef FILT_DMA
    __syncthreads();
    for (int o16 = tid; o16 < ZCH / 4; o16 += 512) *(LAS u32x4*)(Zb + 16 * o16) = (u32x4){0u, 0u, 0u, 0u};
    __syncthreads();
    {
        const float* cw = C.in[10]; const float* cb = C.in[11];
#pragma unroll
        for (int it = 0; it < 8; ++it) {
            const int c = it >> 1, q = tid + 512 * (it & 1), p0 = 8 * q;
            const int c1 = 1024 + d0 + c, c2 = 2048 + d0 + c;
            float s1[8], s2[8];
            short_conv8(HYT + (size_t)c1 * T + utok0, p0, RL, cw[c1], cw[3072 + c1], cw[6144 + c1], cb[c1], s1);
            short_conv8(HYT + (size_t)c2 * T + utok0, p0, RL, cw[c2], cw[3072 + c2], cw[6144 + c2], cb[c2], s2);
            u32x4 w; w.x = cvt_pk_bf16(s1[0] * s2[0], s1[1] * s2[1]); w.y = cvt_pk_bf16(s1[2] * s2[2], s1[3] * s2[3]);
            w.z = cvt_pk_bf16(s1[4] * s2[4], s1[5] * s2[5]); w.w = cvt_pk_bf16(s1[6] * s2[6], s1[7] * s2[7]);
            *(LAS u32x4*)(Zb + c * ZCH + zaddr(ZPOS(q >> 2), q & 3)) = w;
        }
    }
    __syncthreads();
    const int ch = wv >> 1, sub = wv & 1, i = lane & 31, g = lane >> 5;
    const LAS unsigned* FRw = (const LAS unsigned*)(FRb + ch * FRS);
    const LAS unsigned char* Zc = Zb + ch * ZCH;
    f32x16 acc[4];
#pragma unroll
    for (int j = 0; j < 4; ++j)
#pragma unroll
        for (int e = 0; e < 16; ++e) acc[j][e] = 0.f;
    const int mb0 = L - i + 8 * g;
    const int b00 = ZPOS(32 * 4 * sub + i), bstep = smp ? 32 : 60;
    if (smp) {
        toep_run<1>(acc, FRw, mb0, Zc, b00, bstep, g, -127, -96);
        toep_run<3>(acc, FRw, mb0, Zc, b00, bstep, g, -95, -64);
        toep_run<7>(acc, FRw, mb0, Zc, b00, bstep, g, -63, -32);
        toep_run<15>(acc, FRw, mb0, Zc, b00, bstep, g, -31, 31);
        toep_run<14>(acc, FRw, mb0, Zc, b00, bstep, g, 32, 63);
        toep_run<12>(acc, FRw, mb0, Zc, b00, bstep, g, 64, 95);
        toep_run<8>(acc, FRw, mb0, Zc, b00, bstep, g, 96, 127);
    } else {
        toep_run<15>(acc, FRw, mb0, Zc, b00, bstep, g, -7, 7);
    }
    __syncthreads();
    {
        const float* cw = C.in[10]; const float* cb = C.in[11];
#pragma unroll
        for (int it = 0; it < 8; ++it) {
            const int c = it >> 1, q = tid + 512 * (it & 1), p0 = 8 * q, c0 = d0 + c;
            float s0[8];
            short_conv8(HYT + (size_t)c0 * T + utok0, p0, RL, cw[c0], cw[3072 + c0], cw[6144 + c0], cb[c0], s0);
            u32x4 w; w.x = cvt_pk_bf16(s0[0], s0[1]); w.y = cvt_pk_bf16(s0[2], s0[3]); w.z = cvt_pk_bf16(s0[4], s0[5]); w.w = cvt_pk_bf16(s0[6], s0[7]);
            *(LAS u32x4*)(Zb + c * ZCH + zaddr(ZPOS(q >> 2), q & 3)) = w;
        }
    }
    __syncthreads();
    {
        u16* orow = OB + (size_t)(d0 + ch) * T + utok0;
#pragma unroll
        for (int j = 0; j < 4; ++j) {
            const int n = 32 * (4 * sub + j) + i;
#pragma unroll
            for (int q = 0; q < 4; ++q) {
                const int p = n * 32 + 8 * q + 4 * g;
                const u32x2 xr = *(const LAS u32x2*)(Zc + zaddr(b00 + j * bstep, q) + 8 * g);
                u32x2 w; w.x = cvt_pk_bf16(acc[j][4 * q] * bflo(xr.x), acc[j][4 * q + 1] * bfhi(xr.x)); w.y = cvt_pk_bf16(acc[j][4 * q + 2] * bflo(xr.y), acc[j][4 * q + 3] * bfhi(xr.y));
                *(u32x2*)(orow + p) = w;
            }
        }
    }
    __syncthreads();
#undef ZPOS
}

__device__ __forceinline__ void phase_transpose_ob(LAS unsigned char* lds, const Ctx& C) {
    const u16* src = (const u16*)C.out; u16* dst = (u16*)(C.ws + WS_LFF);
    LAS u16* tl = (LAS u16*)lds;
    const int tid = threadIdx.x, r8 = tid >> 3, pc = tid & 7;
    for (int t4 = blockIdx.x; t4 < 16 * 64; t4 += gridDim.x) {
        const int c0 = (t4 >> 6) * 64, k00 = (t4 & 63) * 256;
        u32x4 v[4];
#pragma unroll
        for (int q = 0; q < 4; ++q) v[q] = *(const u32x4*)(src + (size_t)(c0 + r8) * T + k00 + 64 * q + 8 * pc);
#pragma unroll
        for (int q = 0; q < 4; ++q) { LAS unsigned* wp = (LAS unsigned*)(tl + q * 4224 + r8 * 66 + 8 * pc); wp[0] = v[q].x; wp[1] = v[q].y; wp[2] = v[q].z; wp[3] = v[q].w; }
        __syncthreads();
#pragma unroll
        for (int q = 0; q < 4; ++q) {
            unsigned o[4];
#pragma unroll
            for (int e = 0; e < 4; ++e) o[e] = (unsigned)tl[q * 4224 + (8 * pc + 2 * e) * 66 + r8] | ((unsigned)tl[q * 4224 + (8 * pc + 2 * e + 1) * 66 + r8] << 16);
            u32x4 w; w.x = o[0]; w.y = o[1]; w.z = o[2]; w.w = o[3];
            *(u32x4*)(dst + (size_t)(k00 + 64 * q + r8) * D + c0 + 8 * pc) = w;
        }
        __syncthreads();
    }
}

constexpr int SC_QIN = 0, SC_KIN = 8704, SC_KST = 17408, SC_VT = 27648, SC_DEC = 37888, SC_BUF = 38400, SC_HALF = 2 * SC_BUF;

__device__ __forceinline__ void scan_unit(LAS unsigned char* lds_all, const Ctx& C, int pseq, int h, int mode) {
    const int tid = threadIdx.x, dir = tid >> 8, lane = tid & 63, beta = (tid >> 6) & 3, r = lane & 31, hh = lane >> 5;
    const bool want_out = (mode != 1);
    LAS unsigned char* ldsh = lds_all + dir * SC_HALF;
    const u16* Q = (const u16*)(C.ws + WS_Q); const u16* V = (const u16*)(C.ws + WS_V);
    u16* LF = (u16*)(C.ws + (dir ? WS_LFB : WS_LFF));
    float* SEGF = (float*)(C.ws + WS_HB); float* SEGD = (float*)(C.ws + WS_SEGD);
    const int tok_base = pseq * 256, col0 = h * 128;
    const int a_p = 32 * beta + r, rh = hh;

    f32x16 S[4];
#pragma unroll
    for (int al = 0; al < 4; ++al)
#pragma unroll
        for (int e = 0; e < 16; ++e) S[al][e] = 0.f;
    if (mode == 2) {
        const float* s0 = SEGF + (size_t)(((pseq - 32) * 8 + h) * 2 + dir) * 16384;
#pragma unroll
        for (int al = 0; al < 4; ++al)
#pragma unroll
            for (int e = 0; e < 16; ++e) S[al][e] = s0[(32 * al + rowmap(e, hh)) * 128 + 32 * beta + r];
    }
    float dsum = 0.f;
    u16 rl[16], rq[16] = {}, rv[16];
    const u16* Qb = Q + (size_t)tok_base * D + col0; const u16* Vb = V + (size_t)tok_base * D + col0; u16* LFb = LF + (size_t)tok_base * D + col0;
    const int stepD = dir ? -D : D, prow0 = dir ? 31 - 16 * rh : 16 * rh;
#define SCAN_LOAD(nc) do { const int cidx_ = dir ? 7 - (nc) : (nc); const int o_ = (32 * cidx_ + prow0) * D + a_p; \
        _Pragma("unroll") for (int pp = 0; pp < 16; ++pp) { rl[pp] = LFb[(unsigned)(o_ + pp * stepD)]; if (want_out) rq[pp] = Qb[(unsigned)(o_ + pp * stepD)]; rv[pp] = Vb[(unsigned)(o_ + pp * stepD)]; } } while (0)
#define SCAN_PREP(bufp) do { LAS unsigned char* lb_ = (bufp); float b_[16]; float run_ = 0.f; \
        _Pragma("unroll") for (int pp = 0; pp < 16; ++pp) { run_ += (float)__builtin_bit_cast(_Float16, rl[pp]); b_[pp] = run_; } \
        const float other_ = __shfl_xor(run_, 32, 64), blast_ = run_ + other_, dect_ = __expf(blast_), badd_ = rh ? other_ : 0.f; \
        float kst_[16]; \
        _Pragma("unroll") for (int pp = 0; pp < 16; ++pp) { \
            const float kk_ = 1.f - __expf((float)__builtin_bit_cast(_Float16, rl[pp])); \
            const float eb_ = __expf(b_[pp] + badd_), kin_ = kk_ * __builtin_amdgcn_rcpf(eb_); const int p_ = 16 * rh + pp; \
            if (want_out) { *(LAS u16*)(lb_ + SC_QIN + p_ * 272 + a_p * 2) = f2bf(bf2f(rq[pp]) * eb_); \
                            *(LAS u16*)(lb_ + SC_KIN + p_ * 272 + a_p * 2) = f2bf(kin_); } \
            kst_[pp] = kin_ * dect_; } \
        u32x4 w0_, w1_; \
        w0_.x = cvt_pk_bf16(kst_[0], kst_[1]); w0_.y = cvt_pk_bf16(kst_[2], kst_[3]); w0_.z = cvt_pk_bf16(kst_[4], kst_[5]); w0_.w = cvt_pk_bf16(kst_[6], kst_[7]); \
        w1_.x = cvt_pk_bf16(kst_[8], kst_[9]); w1_.y = cvt_pk_bf16(kst_[10], kst_[11]); w1_.z = cvt_pk_bf16(kst_[12], kst_[13]); w1_.w = cvt_pk_bf16(kst_[14], kst_[15]); \
        *(LAS u32x4*)(lb_ + SC_KST + a_p * 80 + 32 * rh) = w0_; *(LAS u32x4*)(lb_ + SC_KST + a_p * 80 + 32 * rh + 16) = w1_; \
        w0_.x = rv[0] | ((unsigned)rv[1] << 16); w0_.y = rv[2] | ((unsigned)rv[3] << 16); w0_.z = rv[4] | ((unsigned)rv[5] << 16); w0_.w = rv[6] | ((unsigned)rv[7] << 16); \
        w1_.x = rv[8] | ((unsigned)rv[9] << 16); w1_.y = rv[10] | ((unsigned)rv[11] << 16); w1_.z = rv[12] | ((unsigned)rv[13] << 16); w1_.w = rv[14] | ((unsigned)rv[15] << 16); \
        *(LAS u32x4*)(lb_ + SC_VT + a_p * 80 + 32 * rh) = w0_; *(LAS u32x4*)(lb_ + SC_VT + a_p * 80 + 32 * rh + 16) = w1_; \
        if (rh == 0) { ((LAS float*)(lb_ + SC_DEC))[a_p] = dect_; dsum += blast_; } } while (0)
    SCAN_LOAD(0);
    SCAN_PREP(ldsh);
    __syncthreads();
    for (int nchunk = 0; nchunk < 8; ++nchunk) {
        const int cidx = dir ? 7 - nchunk : nchunk;
        LAS unsigned char* lds = ldsh + (nchunk & 1) * SC_BUF;
        if (nchunk < 7) SCAN_LOAD(nchunk + 1);
        if (want_out) {
            f32x16 accP;
#pragma unroll
            for (int e = 0; e < 16; ++e) accP[e] = 0.f;
#pragma unroll
            for (int kk = 0; kk < 8; ++kk) {
                const bf16x8 A = *(const LAS bf16x8*)(lds + SC_KIN + r * 272 + 32 * kk + 16 * hh);
                const bf16x8 B = *(const LAS bf16x8*)(lds + SC_QIN + r * 272 + 32 * kk + 16 * hh);
                accP = mfma32(A, B, accP);
            }
#pragma unroll
            for (int e = 0; e < 16; ++e) if (rowmap(e, hh) > r) accP[e] = 0.f;
            f32x16 acco;
#pragma unroll
            for (int e = 0; e < 16; ++e) acco[e] = 0.f;
#pragma unroll
            for (int st = 0; st < 2; ++st) {
                const bf16x8 Pf = pack8(accP[8 * st], accP[8 * st + 1], accP[8 * st + 2], accP[8 * st + 3], accP[8 * st + 4], accP[8 * st + 5], accP[8 * st + 6], accP[8 * st + 7]);
                const bf16x4 lo = *(const LAS bf16x4*)(lds + SC_VT + (32 * beta + r) * 80 + 32 * st + 8 * hh);
                const bf16x4 hi = *(const LAS bf16x4*)(lds + SC_VT + (32 * beta + r) * 80 + 32 * st + 16 + 8 * hh);
                const bf16x8 Bv = (bf16x8){lo[0], lo[1], lo[2], lo[3], hi[0], hi[1], hi[2], hi[3]};
                acco = mfma32(Pf, Bv, acco);
            }
#pragma unroll
            for (int al = 0; al < 4; ++al)
#pragma unroll
                for (int st = 0; st < 2; ++st) {
                    const bf16x4 lo = *(const LAS bf16x4*)(lds + SC_QIN + r * 272 + (32 * al + 16 * st + 4 * hh) * 2);
                    const bf16x4 hi = *(const LAS bf16x4*)(lds + SC_QIN + r * 272 + (32 * al + 16 * st + 8 + 4 * hh) * 2);
                    const bf16x8 Aq = (bf16x8){lo[0], lo[1], lo[2], lo[3], hi[0], hi[1], hi[2], hi[3]};
                    const bf16x8 Bs = pack8(S[al][8 * st], S[al][8 * st + 1], S[al][8 * st + 2], S[al][8 * st + 3], S[al][8 * st + 4], S[al][8 * st + 5], S[al][8 * st + 6], S[al][8 * st + 7]);
                    acco = mfma32(Aq, Bs, acco);
                }
            { const int ob = (32 * cidx + (dir ? 31 - 4 * hh : 4 * hh)) * D + 32 * beta + r;
#pragma unroll
              for (int e = 0; e < 16; ++e) LFb[(unsigned)(ob + ((e & 3) + 8 * (e >> 2)) * stepD)] = f2bf(acco[e]); }
        }
#pragma unroll
        for (int al = 0; al < 4; ++al) {
#pragma unroll
            for (int q = 0; q < 4; ++q) {
                const f32x4 d4 = *(const LAS f32x4*)(lds + SC_DEC + (32 * al + 8 * q + 4 * hh) * 4);
#pragma unroll
                for (int e = 0; e < 4; ++e) S[al][4 * q + e] *= d4[e];
            }
#pragma unroll
            for (int st = 0; st < 2; ++st) {
                const bf16x8 A = *(const LAS bf16x8*)(lds + SC_KST + (32 * al + r) * 80 + 32 * st + 16 * hh);
                const bf16x8 B = *(const LAS bf16x8*)(lds + SC_VT + (32 * beta + r) * 80 + 32 * st + 16 * hh);
                S[al] = mfma32(A, B, S[al]);
            }
        }
        if (nchunk < 7) SCAN_PREP(ldsh + ((nchunk + 1) & 1) * SC_BUF);
        __syncthreads();
    }
#undef SCAN_LOAD
#undef SCAN_PREP
    if (mode == 0) {
        float* ns = C.out + (size_t)T * D + (size_t)((pseq * 2 + dir) * 8 + h) * 16384;
#pragma unroll
        for (int al = 0; al < 4; ++al)
#pragma unroll
            for (int e = 0; e < 16; ++e) ns[(32 * al + rowmap(e, hh)) * 128 + 32 * beta + r] = S[al][e];
    } else if (mode == 1) {
        const int seg = pseq - 32;
        float* Fp = SEGF + (size_t)((seg * 8 + h) * 2 + dir) * 16384;
#pragma unroll
        for (int al = 0; al < 4; ++al)
#pragma unroll
            for (int e = 0; e < 16; ++e) Fp[(32 * al + rowmap(e, hh)) * 128 + 32 * beta + r] = S[al][e];
        if (rh == 0) SEGD[(size_t)((seg * 8 + h) * 2 + dir) * 128 + a_p] = __expf(dsum);
    }
    if (want_out) {
        __syncthreads();
        const u16* OF = (const u16*)(C.ws + WS_LFF); const u16* OBk = (const u16*)(C.ws + WS_LFB); u16* G = (u16*)(C.ws + WS_G);
        const int l16 = tid & 15, trow = tid >> 4, v0 = 8 * l16;
        const f32x4 nw0 = *(const f32x4*)(C.in[9] + v0), nw1 = *(const f32x4*)(C.in[9] + v0 + 4);
        const float nw[8] = {nw0[0], nw0[1], nw0[2], nw0[3], nw1[0], nw1[1], nw1[2], nw1[3]};
#pragma unroll
        for (int ib = 0; ib < 2; ++ib) {
            u32x4 fv[4], bv[4], gv4[4];
#pragma unroll
            for (int it = 0; it < 4; ++it) { const size_t idx = (size_t)(tok_base + trow + 32 * (4 * ib + it)) * D + col0 + v0;
                fv[it] = *(const u32x4*)(OF + idx); bv[it] = *(const u32x4*)(OBk + idx); gv4[it] = *(const u32x4*)(G + idx); }
#pragma unroll
            for (int it = 0; it < 4; ++it) {
                const size_t idx = (size_t)(tok_base + trow + 32 * (4 * ib + it)) * D + col0 + v0;
                const u32x4 f = fv[it], bk = bv[it], gg = gv4[it];
                float o[8] = {bflo(f.x) + bflo(bk.x), bfhi(f.x) + bfhi(bk.x), bflo(f.y) + bflo(bk.y), bfhi(f.y) + bfhi(bk.y),
                              bflo(f.z) + bflo(bk.z), bfhi(f.z) + bfhi(bk.z), bflo(f.w) + bflo(bk.w), bfhi(f.w) + bfhi(bk.w)};
                const float gv[8] = {bflo(gg.x), bfhi(gg.x), bflo(gg.y), bfhi(gg.y), bflo(gg.z), bfhi(gg.z), bflo(gg.w), bfhi(gg.w)};
                float ss = 0.f;
#pragma unroll
                for (int e = 0; e < 8; ++e) ss += o[e] * o[e];
#pragma unroll
                for (int of = 8; of >= 1; of >>= 1) ss += __shfl_xor(ss, of, 64);
                const float rinv = rsqrtf(ss * (1.f / 128.f) + 1e-6f);
#pragma unroll
                for (int e = 0; e < 8; ++e) o[e] = o[e] * rinv * nw[e] * gv[e];
                u32x4 w; w.x = cvt_pk_bf16(o[0], o[1]); w.y = cvt_pk_bf16(o[2], o[3]); w.z = cvt_pk_bf16(o[4], o[5]); w.w = cvt_pk_bf16(o[6], o[7]);
                *(u32x4*)(G + idx) = w;
            }
        }
    }
    __syncthreads();
}

__device__ __forceinline__ void phase_prefix(const Ctx& C) {
    float* SEGF = (float*)(C.ws + WS_HB); const float* SEGD = (const float*)(C.ws + WS_SEGD);
    for (int v = blockIdx.x * 512 + threadIdx.x; v < 32 * 4096; v += gridDim.x * 512) {
        const int chain = v >> 12, e4 = v & 4095, a = e4 >> 5;
        const int sq = chain >> 4, h = (chain >> 1) & 7, dir = chain & 1;
        f32x4 s = *(const f32x4*)(C.in[2] + (size_t)((sq * 2 + dir) * 8 + h) * 16384 + 4 * e4);
#pragma unroll 8
        for (int i = 0; i < 16; ++i) {
            const int seg = sq * 16 + (dir ? 15 - i : i);
            float* fp = SEGF + (size_t)((seg * 8 + h) * 2 + dir) * 16384 + 4 * e4;
            const f32x4 f = *(const f32x4*)fp; const float d = SEGD[(size_t)((seg * 8 + h) * 2 + dir) * 128 + a];
            *(f32x4*)fp = s;
            s = d * s + f;
        }
    }
}

#define XB_TMO      128
#define XB_XCNT(j)  (256  + 64 * (j))
#define XB_XSUB(j)  (1280 + 64 * (j))
#define XB_XGEN(j)  (2304 + 64 * (j))
#define XB_TOP      3328
#define XB_TOPGEN   3392
#define XCD_BAR_WORDS 3456
#define XB_SPIN_CAP (1u << 18)
__device__ __forceinline__ unsigned xb_ld(unsigned* p)              { return __hip_atomic_load(p, __ATOMIC_RELAXED, __HIP_MEMORY_SCOPE_AGENT); }
__device__ __forceinline__ unsigned xb_add(unsigned* p, unsigned v) { return __hip_atomic_fetch_add(p, v, __ATOMIC_RELAXED, __HIP_MEMORY_SCOPE_AGENT); }
__device__ __forceinline__ unsigned xb_xcc_id() { return (unsigned)__builtin_amdgcn_s_getreg((3 << 11) | 20) & 0xFu; }
#define XB_SPIN(cond, bar) do { unsigned _sp = 0; while (cond) { __builtin_amdgcn_s_sleep(1); \
    if ((++_sp & 255u) == 0u) { if (xb_ld(&(bar)[XB_TMO])) break; if (_sp > XB_SPIN_CAP) { atomicAdd(&(bar)[XB_TMO], 1u); break; } } } } while (0)
struct XcdBarrier { unsigned* bar; unsigned x; volatile LAS unsigned* st; };
__device__ __forceinline__ XcdBarrier xcd_barrier_post(unsigned* bar, volatile LAS unsigned* st) {
    XcdBarrier b; b.bar = bar; b.x = xb_xcc_id(); b.st = st;
    if (threadIdx.x == 0) (void)xb_add(&bar[XB_XCNT(b.x)], 1u);
    return b;
}
__device__ __forceinline__ void xcd_barrier_complete(unsigned* bar, unsigned x, unsigned& nloc, unsigned& nx) {
    const unsigned G = gridDim.x * gridDim.y * gridDim.z;
    unsigned sum, cnt, mine, sp = 0u;
    for (;;) {
        sum = 0u; cnt = 0u; mine = 0u;
#pragma unroll
        for (unsigned j = 0; j < 16; ++j) { const unsigned c = xb_ld(&bar[XB_XCNT(j)]); sum += c; cnt += (c > 0u) ? 1u : 0u; mine = (j == x) ? c : mine; }
        if (sum == G) break;
        __builtin_amdgcn_s_sleep(1);
        if ((++sp & 255u) == 0u) { if (xb_ld(&bar[XB_TMO])) break; if (sp > XB_SPIN_CAP) { atomicAdd(&bar[XB_TMO], 1u); break; } }
    }
    nloc = mine > 0u ? mine : 1u; nx = cnt > 0u ? cnt : 1u;
}
__device__ __forceinline__ void xcd_barrier(const XcdBarrier& b) {
    asm volatile("s_waitcnt vmcnt(0)" ::: "memory");
    __syncthreads();
    if (threadIdx.x == 0) {
        unsigned* bar = b.bar;
        __builtin_amdgcn_s_waitcnt(0);
        unsigned nloc = b.st[0], nx = b.st[1];
        if (nloc == 0u) { xcd_barrier_complete(bar, b.x, nloc, nx); b.st[0] = nloc; b.st[1] = nx; }
        const unsigned old = xb_add(&bar[XB_XSUB(b.x)], 1u);
        const unsigned gen = old / nloc;
        if (old + 1u == (gen + 1u) * nloc) {
            __builtin_amdgcn_fence(__ATOMIC_RELEASE, "agent");
            asm volatile("s_waitcnt vmcnt(0)" ::: "memory");
            const unsigned og = xb_add(&bar[XB_TOP], 1u);
            const unsigned tg = og / nx;
            if (og + 1u == (tg + 1u) * nx) xb_add(&bar[XB_TOPGEN], 1u);
            else XB_SPIN(xb_ld(&bar[XB_TOPGEN]) == tg, bar);
            __builtin_amdgcn_fence(__ATOMIC_ACQUIRE, "agent");
            xb_add(&bar[XB_XGEN(b.x)], 1u);
            asm volatile("s_waitcnt vmcnt(0)" ::: "memory");
        } else {
            XB_SPIN(xb_ld(&bar[XB_XGEN(b.x)]) == gen, bar);
            __builtin_amdgcn_fence(__ATOMIC_ACQUIRE, "agent");
            asm volatile("s_waitcnt vmcnt(0)" ::: "memory");
        }
    }
    __syncthreads();
}

constexpr int N_PHASES = 15;
__global__ void __launch_bounds__(512, 2) mega_fwd(Params P) {
    extern __shared__ __attribute__((aligned(16))) unsigned char lds_raw[];
    LAS unsigned char* lds = (LAS unsigned char*)lds_raw;
    cg::grid_group grid = cg::this_grid();
    Ctx C;
#pragma unroll
    for (int i = 0; i < 30; ++i) C.in[i] = P.in[i];
    C.out = P.out; C.ws = P.ws;
    unsigned char* ws = P.ws;
    const int lo = P.ph_lo, hi = P.ph_hi;
    const int G = gridDim.x, bid = blockIdx.x;
    volatile LAS unsigned* xbw = (volatile LAS unsigned*)(lds + LDS_XB_OFF);
    if (threadIdx.x < 4) xbw[threadIdx.x] = 0u;
    __syncthreads();
    XcdBarrier xbar = xcd_barrier_post((unsigned*)(ws + WS_BAR), xbw);
#ifndef PHM
#define PHM 0x7fff
#endif
#define IN(k) (((PHM >> (k)) & 1) && lo <= (k) && (k) < hi)
#ifndef REPEAT_MASK
#define REPEAT_MASK 0
#endif
#define NREP(k) ((((REPEAT_MASK) >> (k)) & 1) ? 2 : 1)
#define SEAM(k) do { if (IN(k) && IN((k) + 1)) { if (hi > 1000) grid.sync(); else xcd_barrier(xbar); } } while (0)

    if (IN(0)) for (int rep_ = 0; rep_ < NREP(0); ++rep_) { phase_prep(lds, C); }
    SEAM(0);
    if (IN(1)) for (int rep_ = 0; rep_ < NREP(1); ++rep_) { phase_modulate(C); }
    SEAM(1);
    if (IN(2)) for (int rep_ = 0; rep_ < NREP(2); ++rep_) {
        pg8::Gemm g{1024, (size_t)128 * 1024 * 2, (size_t)128 * 1024 * 2};
        pg8::Sched S{}; S.nM = 12; S.nN = 64; S.nwg = 768; S.G = G; S.c = bid; S.kind = 0;
        S.A = (const char*)(ws + WS_WIN) + (size_t)5120 * 2048; S.B = (const char*)(ws + WS_HB); S.tsA = (size_t)256 * 2048; S.tsB = (size_t)256 * 2048;
        EpiBf E{(u16*)(ws + WS_R60), T};
        pg8::gemm_phase<EpiBf>(lds, g, S, E);
    }
    SEAM(2);
    if (IN(3)) for (int rep_ = 0; rep_ < NREP(3); ++rep_) { for (int u = bid; u < 512; u += G) conv_unit(lds, C, u >> 8, u & 255); }
    SEAM(3);
    if (IN(4)) for (int rep_ = 0; rep_ < NREP(4); ++rep_) {
        pg8::Gemm g{1024, (size_t)128 * 1024 * 2, (size_t)128 * 1024 * 2};
        pg8::Sched S{}; S.nM = 64; S.nN = 28; S.nwg = 1792; S.G = G; S.c = bid; S.kind = 1;
        S.A = (const char*)(ws + WS_HB); S.B = (const char*)(ws + WS_WIN); S.tsA = (size_t)256 * 2048; S.tsB = 0;
        EpiIn E; E.out[0] = (u16*)(ws + WS_Q); E.out[1] = (u16*)(ws + WS_LFF); E.out[2] = (u16*)(ws + WS_LFB); E.out[3] = (u16*)(ws + WS_V);
        E.out[4] = (u16*)(ws + WS_G); E.out[5] = (u16*)(ws + WS_GA); E.out[6] = (u16*)((unsigned char*)P.out + 32 * MiB); E.LB = (const float*)(ws + WS_LB);
        pg8::gemm_phase<EpiIn>(lds, g, S, E);
    }
    SEAM(4);
    if (IN(5)) for (int rep_ = 0; rep_ < NREP(5); ++rep_) {
        for (int u = bid; u < 512; u += G) { if (u < 256) scan_unit(lds, C, u >> 3, u & 7, 0); else scan_unit(lds, C, 32 + ((u - 256) >> 3), u & 7, 1); }
    }
    SEAM(5);
    if (IN(6)) { phase_prefix(C); }
    SEAM(6);
    if (IN(7)) for (int rep_ = 0; rep_ < NREP(7); ++rep_) { for (int u = bid; u < 256; u += G) scan_unit(lds, C, 32 + (u >> 3), u & 7, 2); }
    SEAM(7);
    if (IN(8)) for (int rep_ = 0; rep_ < NREP(8); ++rep_) { phase_transpose_ob(lds, C); }
    SEAM(8);
    if (IN(9)) for (int rep_ = 0; rep_ < NREP(9); ++rep_) {
        pg8::Gemm g{1024, (size_t)128 * 1024 * 2, (size_t)128 * 1024 * 2};
        pg8::Sched S{}; S.nM = 64; S.nN = 4; S.nwg = 256; S.G = G; S.c = bid; S.kind = 2;
        S.A = (const char*)(ws + WS_G); S.A2 = (const char*)(ws + WS_LFF); S.B = (const char*)(ws + WS_WPA); S.B2 = (const char*)(ws + WS_WPB); S.tsA = (size_t)256 * 2048; S.tsB = (size_t)256 * 2048;
        EpiMerge E{(const u16*)(ws + WS_GA), (const u16*)((unsigned char*)P.out + 32 * MiB), (u16*)(ws + WS_T1)};
        pg8::gemm_phase<EpiMerge>(lds, g, S, E);
    }
    SEAM(9);
    if (IN(10)) for (int rep_ = 0; rep_ < NREP(10); ++rep_) {
        pg8::Gemm g{1024, (size_t)128 * 1024 * 2, (size_t)128 * 1024 * 2};
        pg8::Sched S{}; S.nM = 64; S.nN = 4; S.nwg = 256; S.G = G; S.c = bid; S.kind = 0;
        S.A = (const char*)(ws + WS_T1); S.B = (const char*)(ws + WS_WOUT); S.tsA = (size_t)256 * 2048; S.tsB = (size_t)256 * 2048;
        EpiRes<false> E{P.in[0], P.in[1], (const float*)(ws + WS_MOD) + 2 * 1024, (u16*)(ws + WS_U1)};
        pg8::gemm_phase<EpiRes<false>>(lds, g, S, E);
    }
    SEAM(10);
    if (IN(11)) for (int rep_ = 0; rep_ < NREP(11); ++rep_) {
        phase_ln<true>(C, (const u16*)(ws + WS_U1), nullptr, (u16*)(ws + WS_X1), P.in[24], P.in[25], (u16*)(ws + WS_HB), 4, 3);
        __syncthreads();
        for (int u = bid; u < 352; u += G) convert_tile4(lds, P.in[26], (u16*)(ws + WS_WFIN), 1024, 2 * DFF, u);
        if (G != 256) for (int u = bid; u < 176; u += G) convert_tile4(lds, P.in[27], (u16*)(ws + WS_WFOUT), DFF, 1024, u);
    }
    SEAM(11);
    if (IN(12)) for (int rep_ = 0; rep_ < NREP(12); ++rep_) {
        pg8::Gemm g{1024, (size_t)128 * 1024 * 2, (size_t)DFF * 1024 * 2};
        pg8::Sched S{}; S.nM = 64; S.nN = 22; S.nwg = 1408; S.G = G; S.c = bid; S.kind = 0;
        S.A = (const char*)(ws + WS_HB); S.B = (const char*)(ws + WS_WFIN); S.tsA = (size_t)256 * 2048; S.tsB = (size_t)128 * 2048;
        EpiGlu E{(u16*)(ws + WS_FF)};
        pg8::gemm_phase<EpiGlu>(lds, g, S, E);
        if (G == 256 && bid >= 128) for (int u = bid - 128; u < 176; u += 128) convert_tile4(lds, P.in[27], (u16*)(ws + WS_WFOUT), DFF, 1024, u);
    }
    SEAM(12);
    if (IN(13)) for (int rep_ = 0; rep_ < NREP(13); ++rep_) {
        pg8::Gemm g{DFF, (size_t)128 * DFF * 2, (size_t)128 * DFF * 2};
        pg8::Sched S{}; S.nM = 64; S.nN = 4; S.nwg = 256; S.G = G; S.c = bid; S.kind = 0;
        S.A = (const char*)(ws + WS_FF); S.B = (const char*)(ws + WS_WFOUT); S.tsA = (size_t)256 * DFF * 2; S.tsB = (size_t)256 * DFF * 2;
        EpiRes<true> E{(const void*)(ws + WS_X1), nullptr, (const float*)(ws + WS_MOD) + 5 * 1024, (u16*)(ws + WS_HB)};
        pg8::gemm_phase<EpiRes<true>>(lds, g, S, E);
    }
    SEAM(13);
    if (IN(14)) for (int rep_ = 0; rep_ < NREP(14); ++rep_) { phase_ln<false>(C, (const u16*)(ws + WS_HB), P.out, nullptr, P.in[28], P.in[29], nullptr, 0, 0); }
#ifdef DEBUG_SANITIZE
    if (lo == 15) {
        const unsigned* w32 = (const unsigned*)P.ws; unsigned* o32 = (unsigned*)P.out;
        const size_t n = (size_t)T * D, nall = n + 8388608;
        for (size_t i = (size_t)bid * 512 + threadIdx.x; i < nall; i += (size_t)G * 512) {
            unsigned w = o32[i];
#ifdef DEBUG_FOLD
            if (i < n) w ^= w32[i] ^ w32[i + n] ^ w32[i + 2 * n] ^ w32[i + 3 * n];
#endif
            float v = __uint_as_float(w); if (!(fabsf(v) < 1e30f)) v = 0.f;
            P.out[i] = v;
        }
    }
#endif
#undef IN
#undef SEAM
}

extern "C" void kernel_launch(void* const* d_in, const int* in_sizes, int n_in, void* d_out, int out_size, void* d_ws, size_t ws_size, hipStream_t stream) {
    static int grid_blocks = 0;
    if (!grid_blocks) {
        int dev = 0, cus = 0, per_cu = 0;
        hipGetDevice(&dev);
        hipDeviceGetAttribute(&cus, hipDeviceAttributeMultiprocessorCount, dev);
        hipFuncSetAttribute((const void*)mega_fwd, hipFuncAttributeMaxDynamicSharedMemorySize, LDS_BYTES);
        hipOccupancyMaxActiveBlocksPerMultiprocessor(&per_cu, (const void*)mega_fwd, 512, LDS_BYTES);
        if (per_cu < 1) { fprintf(stderr, "occupancy query says %d blocks per CU\n", per_cu); per_cu = 1; }
        if (per_cu > 1) per_cu = 1;
        grid_blocks = cus * per_cu;
        (void)hipGetLastError();
    }
    Params p{};
    for (int i = 0; i < 30; ++i) p.in[i] = (const float*)d_in[i];
    p.out = (float*)d_out; p.ws = (unsigned char*)d_ws;
#if SPLIT_LAUNCH
#ifndef PH_END
#define PH_END N_PHASES
#endif
#ifdef DEBUG_SANITIZE
    const int n_launch = 16;
#else
    const int n_launch = PH_END;
#endif
    for (int ph = 0; ph < n_launch; ++ph) {
        if (ph >= PH_END && ph < 15) continue;
        p.ph_lo = ph; p.ph_hi = ph + 1;
        hipLaunchKernelGGL(mega_fwd, dim3(grid_blocks), dim3(512), LDS_BYTES, stream, p);
    }
#else
    p.ph_lo = 0; p.ph_hi = N_PHASES;
    (void)hipMemsetAsync((char*)d_ws + WS_BAR, 0, XCD_BAR_WORDS * sizeof(unsigned), stream);
    void* args[] = {&p};
    hipError_t e = hipLaunchCooperativeKernel((const void*)mega_fwd, dim3(grid_blocks), dim3(512), args, LDS_BYTES, stream);
    if (e != hipSuccess) fprintf(stderr, "cooperative launch failed: %s (grid %d)\n", hipGetErrorString(e), grid_blocks);
#endif
}
```

```cpp
#include <hip/hip_runtime.h>
#include <hip/hip_cooperative_groups.h>
#include <cstdio>
namespace cg = cooperative_groups;

#define CONV_REP_MAIN 1
#ifndef SPLIT_LAUNCH
#define SPLIT_LAUNCH 0
#endif

#define LAS __attribute__((address_space(3)))
typedef unsigned short u16;
typedef short bf16x8 __attribute__((ext_vector_type(8)));
typedef short bf16x4 __attribute__((ext_vector_type(4)));
typedef float f32x4 __attribute__((ext_vector_type(4)));
typedef float f32x16 __attribute__((ext_vector_type(16)));
typedef unsigned u32x4 __attribute__((ext_vector_type(4)));
typedef unsigned u32x2 __attribute__((ext_vector_type(2)));
typedef _Float16 h16x2 __attribute__((ext_vector_type(2)));

constexpr int T = 16384, D = 1024, NIN = 10240, DFF = 2816, NMOD = 6144;
constexpr size_t MiB = 1u << 20;
constexpr int LDS_BYTES = 155648 + 64;
constexpr int LDS_XB_OFF = 155648;
constexpr float ALPHA = 1.189207115002721f;

constexpr size_t WS_WIN = 0, WS_WPA = 20 * MiB, WS_WPB = 22 * MiB, WS_WOUT = 24 * MiB;
constexpr size_t WS_MISC = 26 * MiB;
constexpr size_t WS_MOD = WS_MISC, WS_LB = WS_MISC + 128 * 1024, WS_H3P = WS_MISC + 256 * 1024, WS_H3S = WS_MISC + 512 * 1024, WS_SEGD = WS_MISC + 1536 * 1024, WS_BAR = WS_MISC + 1792 * 1024;
constexpr size_t WS_HB = 28 * MiB;
constexpr size_t WS_R60 = 60 * MiB;
constexpr size_t WS_Q = 60 * MiB, WS_LFF = 92 * MiB, WS_LFB = 124 * MiB, WS_V = 156 * MiB, WS_G = 188 * MiB, WS_GA = 220 * MiB;
constexpr size_t WS_T1 = 60 * MiB, WS_U1 = 92 * MiB, WS_X1 = 156 * MiB, WS_FF = 60 * MiB, WS_WFIN = 220 * MiB, WS_WFOUT = 232 * MiB;

struct Params { const float* in[30]; float* out; unsigned char* ws; int ph_lo, ph_hi; };

struct Ctx {
    const float* in[30]; float* out; unsigned char* ws;
    __device__ __forceinline__ const float* xrow(int tok) const { return tok < 8192 ? in[0] + (size_t)tok * D : in[1] + (size_t)(tok - 8192) * D; }
};
__device__ __forceinline__ int cid_of(int tok) { return tok < 8192 ? 0 : 1 + ((tok - 8192) >> 12); }

typedef __bf16 bf16v2 __attribute__((ext_vector_type(2)));
typedef float f32x2 __attribute__((ext_vector_type(2)));
__device__ __forceinline__ unsigned cvt_pk_bf16(float lo, float hi) { f32x2 v = {lo, hi}; bf16v2 b = __builtin_convertvector(v, bf16v2); return __builtin_bit_cast(unsigned, b); }
__device__ __forceinline__ float bf2f(u16 b) { return __uint_as_float(((unsigned)b) << 16); }
__device__ __forceinline__ float bflo(unsigned w) { return __uint_as_float(w << 16); }
__device__ __forceinline__ float bfhi(unsigned w) { return __uint_as_float(w & 0xffff0000u); }
__device__ __forceinline__ u16 f2bf(float f) { return (u16)(cvt_pk_bf16(f, 0.f) & 0xffffu); }
__device__ __forceinline__ float sigmoid_f(float x) { return __builtin_amdgcn_rcpf(1.f + __expf(-x)); }
__device__ __forceinline__ float silu_f(float x) { return x * __builtin_amdgcn_rcpf(1.f + __expf(-x)); }
__device__ __forceinline__ float red2pi(float x) { const float k = rintf(x * 0.15915494309189535f); float r = fmaf(-k, 6.2831854820251465f, x); return fmaf(k, 1.7484555e-7f, r); }
__device__ __forceinline__ float my_sin(float x) { return __sinf(red2pi(x)); }
__device__ __forceinline__ float my_cos(float x) { return __cosf(red2pi(x)); }
__device__ __forceinline__ int rowmap(int reg, int hh) { return (reg & 3) + 8 * (reg >> 2) + 4 * hh; }
__device__ __forceinline__ f32x16 mfma32(bf16x8 a, bf16x8 b, f32x16 c) { return __builtin_amdgcn_mfma_f32_32x32x16_bf16(a, b, c, 0, 0, 0); }
__device__ __forceinline__ bf16x8 pack8(float a0, float a1, float a2, float a3, float a4, float a5, float a6, float a7) {
    u32x4 w; w.x = cvt_pk_bf16(a0, a1); w.y = cvt_pk_bf16(a2, a3); w.z = cvt_pk_bf16(a4, a5); w.w = cvt_pk_bf16(a6, a7);
    return __builtin_bit_cast(bf16x8, w);
}

namespace pg8 {
constexpr int BM = 256, BK = 64, HALF = 128, HTB = HALF * BK * 2, STAGE_BYTES = 8 * HTB, NXCD = 8, WGM = 4;
__device__ __forceinline__ int lds_byte(int r, int c) { const int st = (r >> 4) * 2 + (c >> 5), rr = r & 15, cc = c & 31, ob = rr * 64 + cc * 2; return st * 1024 + (ob ^ (((ob >> 9) & 1) << 5)); }
__device__ __forceinline__ void stage_rc(int b, int& R, int& C) { const int st = b / 1024, sb = b % 1024, swz = sb ^ (((sb >> 9) & 1) << 5); R = (st >> 1) * 16 + swz / 64; C = (st & 1) * 32 + (swz % 64) / 2; }
__device__ __forceinline__ int perm32(int rho) { const int n = rho >> 4, i = rho & 15; return 8 * (i >> 2) + 4 * n + (i & 3); }

struct Unit { const char* A; const char* B; int pm, pn, aux, pad; };
struct Gemm { int K; size_t hstepA, hstepB; };

struct Sched {
    int nM, nN, nwg, G, c, kind;
    const char* A; const char* B; const char* A2; const char* B2; size_t tsA, tsB;
    __device__ __forceinline__ void map(int wgid, int& pm, int& pn) const {
        { const int q = nwg / NXCD, r = nwg % NXCD, xcd = wgid % NXCD, off = wgid / NXCD; wgid = (xcd < r ? xcd * (q + 1) : r * (q + 1) + (xcd - r) * q) + off; }
        const int nig = WGM * nN, gid = wgid / nig, fm = gid * WGM, gsz = (nM - fm) < WGM ? (nM - fm) : WGM;
        pm = fm + ((wgid % nig) % gsz); pn = (wgid % nig) / gsz;
    }
    __device__ __forceinline__ bool next(int i, Unit& u) const {
        if (kind == 2) {
            const long L = (long)(i >> 1) * G + c; if (L >= nwg) return false;
            int pm, pn; map((int)L, pm, pn); u.pm = pm; u.pn = pn; u.aux = i & 1; u.pad = 0;
            u.A = ((i & 1) ? A2 : A) + (size_t)pm * tsA; u.B = ((i & 1) ? B2 : B) + (size_t)pn * tsB; return true;
        }
        const long L = (long)i * G + c; if (L >= nwg) return false;
        int pm, pn; map((int)L, pm, pn); u.pm = pm; u.pn = pn; u.aux = 0; u.pad = 0;
        u.A = A + (size_t)pm * tsA;
        if (kind == 1) { const int seg = pn >> 2; const int rows = (seg < 5 ? seg * 1024 : 8192 + (seg - 5) * 1024) + (pn & 3) * 256; u.B = B + (size_t)rows * (D * 2); }
        else u.B = B + (size_t)pn * tsB;
        return true;
    }
};

template <class Epi, bool ALIGN_EPI = true, bool SP2 = true>
__device__ __forceinline__ void gemm_phase(LAS unsigned char* lds, const Gemm g, const Sched& S, const Epi& E) {
    const int tid = threadIdx.x, wid = __builtin_amdgcn_readfirstlane(tid >> 6), lane = tid & 63, wr = wid >> 2, wc = wid & 3, fr = lane & 15, fq = lane >> 4;
    const int K = g.K, nt = K / BK;
    unsigned voffA[2], voffB[2];
#pragma unroll
    for (int i = 0; i < 2; ++i) { int R, C; stage_rc(tid * 16 + i * 8192, R, C); const int Rb = (R & ~31) + perm32(R & 31);
        voffA[i] = (unsigned)(R * K + C) * 2u; voffB[i] = (unsigned)(Rb * K + C) * 2u; }
    const size_t kstep = (size_t)(BK * 2);
    const size_t hsA = g.hstepA, hsB = g.hstepB;
    const unsigned ldsw = (unsigned)wid * 1024u;
    const int aoff = lds_byte(wr * 64 + fr, fq * 8), boff = lds_byte(wc * 32 + fr, fq * 8);
#define PG8_SA(b, h) (((b) * 2 + (h)) * HTB)
#define PG8_SB(b, h) ((4 + (b) * 2 + (h)) * HTB)
#define PG8_STAGE(bufoff, gbase, voff) do { _Pragma("unroll") for (int _i = 0; _i < 2; ++_i) \
        __builtin_amdgcn_global_load_lds((const unsigned*)((const char*)(gbase) + (voff)[_i]), (LAS unsigned*)(lds + (bufoff) + ldsw + _i * 8192), 16, 0, 0); } while (0)
#define PG8_LDA(dst, b, h) do { _Pragma("unroll") for (int m = 0; m < 4; ++m) _Pragma("unroll") for (int k = 0; k < 2; ++k) dst[m][k] = *(const LAS bf16x8*)(lds + PG8_SA(b, h) + aoff + m * 2048 + k * 1024); } while (0)
#define PG8_LDB(dst, b, h) do { _Pragma("unroll") for (int n = 0; n < 2; ++n) _Pragma("unroll") for (int k = 0; k < 2; ++k) dst[n][k] = *(const LAS bf16x8*)(lds + PG8_SB(b, h) + boff + n * 2048 + k * 1024); } while (0)
#define PG8_MMA(ai, bj, At, Bt) do { __builtin_amdgcn_s_setprio(1); _Pragma("unroll") for (int m = 0; m < 4; ++m) _Pragma("unroll") for (int n = 0; n < 2; ++n) _Pragma("unroll") for (int k = 0; k < 2; ++k) \
        acc[ai][bj][m][n] = __builtin_amdgcn_mfma_f32_16x16x32_bf16(Bt[n][k], At[m][k], acc[ai][bj][m][n], 0, 0, 0); __builtin_amdgcn_s_setprio(0); } while (0)
#define PG8_WAIT_V(n) asm volatile("s_waitcnt vmcnt(" #n ")" ::: "memory")
#define PG8_WAIT_L(n) asm volatile("s_waitcnt lgkmcnt(" #n ")" ::: "memory")
#define PG8_BAR __builtin_amdgcn_s_barrier()
#define PG8_SCHED __builtin_amdgcn_sched_barrier(0)
    Unit cur, nxt; int ui = 0;
    if (!S.next(0, cur)) return;
    f32x4 acc[2][2][4][2];
#pragma unroll
    for (int a = 0; a < 2; ++a)
#pragma unroll
        for (int b = 0; b < 2; ++b)
#pragma unroll
            for (int m = 0; m < 4; ++m)
#pragma unroll
                for (int n = 0; n < 2; ++n) acc[a][b][m][n] = (f32x4){0.f, 0.f, 0.f, 0.f};
    bf16x8 At[4][2], B0[2][2], B1[2][2];
    const char* cA = cur.A; const char* cB = cur.B;
    if constexpr (SP2) {
        PG8_STAGE(PG8_SB(0, 0), cB, voffB); PG8_STAGE(PG8_SB(0, 1), cB + hsB, voffB); PG8_STAGE(PG8_SA(0, 0), cA, voffA); PG8_STAGE(PG8_SA(0, 1), cA + hsA, voffA);
        if (wr == 1) PG8_BAR;
        PG8_WAIT_V(2); PG8_BAR;
        PG8_STAGE(PG8_SB(1, 0), cB + kstep, voffB); PG8_STAGE(PG8_SA(1, 0), cA + kstep, voffA); PG8_STAGE(PG8_SB(1, 1), cB + hsB + kstep, voffB);
        PG8_WAIT_V(6); PG8_BAR;
    } else {
        PG8_STAGE(PG8_SB(0, 0), cB, voffB); PG8_STAGE(PG8_SA(0, 0), cA, voffA); PG8_STAGE(PG8_SB(0, 1), cB + hsB, voffB); PG8_STAGE(PG8_SA(0, 1), cA + hsA, voffA);
        if (wr == 1) PG8_BAR;
        PG8_WAIT_V(4); PG8_BAR;
        PG8_STAGE(PG8_SB(1, 0), cB + kstep, voffB); PG8_STAGE(PG8_SA(1, 0), cA + kstep, voffA); PG8_STAGE(PG8_SB(1, 1), cB + hsB + kstep, voffB);
        PG8_WAIT_V(6); PG8_BAR;
    }
    for (;;) {
        const bool has_next = S.next(ui + 1, nxt);
        const char* nA = has_next ? nxt.A : cA; const char* nB = has_next ? nxt.B : cB;
        for (int t = 0; t < nt; t += 2) {
            const bool last = (t == nt - 2);
            const char* a1 = cA + (size_t)(t + 1) * kstep;
            const char* a2 = last ? nA : cA + (size_t)(t + 2) * kstep; const char* b2 = last ? nB : cB + (size_t)(t + 2) * kstep;
            const char* a3 = a2 + kstep; const char* b3 = b2 + kstep;
            if constexpr (SP2) {
            PG8_LDB(B0, 0, 0); PG8_LDB(B1, 0, 1); PG8_SCHED; PG8_LDA(At, 0, 0); PG8_STAGE(PG8_SA(1, 1), a1 + hsA, voffA);
            PG8_WAIT_V(8); PG8_WAIT_L(0); PG8_BAR; PG8_MMA(0, 0, At, B0); PG8_MMA(0, 1, At, B1); PG8_BAR; PG8_SCHED;
            PG8_LDA(At, 0, 1); PG8_STAGE(PG8_SB(0, 0), b2, voffB); PG8_STAGE(PG8_SB(0, 1), b2 + hsB, voffB); PG8_STAGE(PG8_SA(0, 0), a2, voffA);
            PG8_WAIT_V(8); PG8_WAIT_L(0); PG8_BAR; PG8_MMA(1, 0, At, B0); PG8_MMA(1, 1, At, B1); PG8_BAR; PG8_SCHED;
            PG8_LDB(B0, 1, 0); PG8_LDB(B1, 1, 1); PG8_SCHED; PG8_LDA(At, 1, 0); PG8_STAGE(PG8_SA(0, 1), a2 + hsA, voffA);
            PG8_WAIT_V(8); PG8_WAIT_L(0); PG8_BAR; PG8_MMA(0, 0, At, B0); PG8_MMA(0, 1, At, B1); PG8_BAR; PG8_SCHED;
            PG8_LDA(At, 1, 1); PG8_STAGE(PG8_SB(1, 0), b3, voffB); PG8_STAGE(PG8_SB(1, 1), b3 + hsB, voffB); PG8_STAGE(PG8_SA(1, 0), a3, voffA);
            PG8_WAIT_V(8); PG8_WAIT_L(0); PG8_BAR; PG8_MMA(1, 0, At, B0); PG8_MMA(1, 1, At, B1); PG8_BAR; PG8_SCHED;
            } else {
            PG8_LDB(B0, 0, 0); PG8_SCHED; PG8_LDA(At, 0, 0); PG8_STAGE(PG8_SA(1, 1), a1 + hsA, voffA);
            PG8_WAIT_L(8); PG8_BAR; PG8_WAIT_L(0); PG8_MMA(0, 0, At, B0); PG8_BAR; PG8_SCHED;
            PG8_LDB(B1, 0, 1); PG8_STAGE(PG8_SB(0, 0), b2, voffB);
            PG8_BAR; PG8_WAIT_L(0); PG8_MMA(0, 1, At, B1); PG8_BAR;
            PG8_LDA(At, 0, 1); PG8_STAGE(PG8_SA(0, 0), a2, voffA);
            PG8_BAR; PG8_WAIT_L(0); PG8_MMA(1, 0, At, B0); PG8_BAR; PG8_SCHED;
            PG8_STAGE(PG8_SB(0, 1), b2 + hsB, voffB);
            PG8_WAIT_V(6); PG8_BAR; PG8_MMA(1, 1, At, B1); PG8_BAR;
            PG8_LDB(B0, 1, 0); PG8_SCHED; PG8_LDA(At, 1, 0); PG8_STAGE(PG8_SA(0, 1), a2 + hsA, voffA);
            PG8_WAIT_L(8); PG8_BAR; PG8_WAIT_L(0); PG8_MMA(0, 0, At, B0); PG8_BAR; PG8_SCHED;
            PG8_LDB(B1, 1, 1); PG8_STAGE(PG8_SB(1, 0), b3, voffB);
            PG8_BAR; PG8_WAIT_L(0); PG8_MMA(0, 1, At, B1); PG8_BAR;
            PG8_LDA(At, 1, 1); PG8_STAGE(PG8_SA(1, 0), a3, voffA);
            PG8_BAR; PG8_WAIT_L(0); PG8_MMA(1, 0, At, B0); PG8_BAR; PG8_SCHED;
            PG8_STAGE(PG8_SB(1, 1), b3 + hsB, voffB);
            PG8_WAIT_V(6); PG8_BAR; PG8_MMA(1, 1, At, B1); PG8_BAR;
            }
        }
        if constexpr (ALIGN_EPI) { if (wr == 0) PG8_BAR; }
        E(acc, cur, wr, wc, fr, fq);
        if (!has_next) break;
        if (!E.keep(cur)) {
#pragma unroll
            for (int a = 0; a < 2; ++a)
#pragma unroll
                for (int b = 0; b < 2; ++b)
#pragma unroll
                    for (int m = 0; m < 4; ++m)
#pragma unroll
                        for (int n = 0; n < 2; ++n) acc[a][b][m][n] = (f32x4){0.f, 0.f, 0.f, 0.f};
        }
        cur = nxt; cA = nA; cB = nB; ++ui;
        if constexpr (ALIGN_EPI) { if (wr == 1) PG8_BAR; }
    }
    PG8_WAIT_V(0);
    if constexpr (!ALIGN_EPI) { if (wr == 0) PG8_BAR; }
    PG8_BAR;
#undef PG8_SA
#undef PG8_SB
#undef PG8_STAGE
#undef PG8_LDA
#undef PG8_LDB
#undef PG8_MMA
#undef PG8_WAIT_V
#undef PG8_WAIT_L
#undef PG8_BAR
#undef PG8_SCHED
}
}

typedef f32x4 AccT[2][2][4][2];

struct EpiIn {
    u16* out[7]; const float* LB;
    __device__ __forceinline__ bool keep(const pg8::Unit&) const { return false; }
    template <int ACT> __device__ __forceinline__ void run(AccT& acc, const pg8::Unit& u, int wr, int wc, int fr, int fq, u16* O, const float* lbp) const {
        const int row0 = u.pm * 256 + wr * 64 + fr, colb = (u.pn & 3) * 256 + wc * 32 + 8 * fq;
#pragma unroll
        for (int bj = 0; bj < 2; ++bj) {
            const int col = colb + bj * 128;
            float lbv[8];
            if (ACT == 2) { const f32x4 l0 = *(const f32x4*)(lbp + col), l1 = *(const f32x4*)(lbp + col + 4);
                lbv[0] = l0[0]; lbv[1] = l0[1]; lbv[2] = l0[2]; lbv[3] = l0[3]; lbv[4] = l1[0]; lbv[5] = l1[1]; lbv[6] = l1[2]; lbv[7] = l1[3]; }
#pragma unroll
            for (int ai = 0; ai < 2; ++ai)
#pragma unroll
                for (int m = 0; m < 4; ++m) {
                    const int row = row0 + ai * 128 + m * 16;
                    float v[8];
#pragma unroll
                    for (int e = 0; e < 4; ++e) { v[e] = acc[ai][bj][m][0][e]; v[4 + e] = acc[ai][bj][m][1][e]; }
                    u32x4 w;
                    if (ACT == 2) {
                        unsigned ww[4];
#pragma unroll
                        for (int e = 0; e < 4; ++e) {
                            const float f0 = lbv[2 * e] + (1.f - lbv[2 * e]) * sigmoid_f(v[2 * e]);
                            const float f1 = lbv[2 * e + 1] + (1.f - lbv[2 * e + 1]) * sigmoid_f(v[2 * e + 1]);
                            h16x2 hp; hp.x = (_Float16)__logf(f0); hp.y = (_Float16)__logf(f1);
                            ww[e] = __builtin_bit_cast(unsigned, hp);
                        }
                        w.x = ww[0]; w.y = ww[1]; w.z = ww[2]; w.w = ww[3];
                    } else {
#pragma unroll
                        for (int e = 0; e < 8; ++e) { if (ACT == 1) v[e] = silu_f(v[e]); if (ACT == 3) v[e] = sigmoid_f(v[e]); }
                        w.x = cvt_pk_bf16(v[0], v[1]); w.y = cvt_pk_bf16(v[2], v[3]); w.z = cvt_pk_bf16(v[4], v[5]); w.w = cvt_pk_bf16(v[6], v[7]);
                    }
                    *(u32x4*)(O + (size_t)row * D + col) = w;
                }
        }
    }
    __device__ __forceinline__ void operator()(AccT& acc, const pg8::Unit& u, int wr, int wc, int fr, int fq) const {
        const int seg = u.pn >> 2; u16* O = seg == 0 ? out[0] : seg == 1 ? out[1] : seg == 2 ? out[2] : seg == 3 ? out[3] : seg == 4 ? out[4] : seg == 5 ? out[5] : out[6];
        if (seg == 0 || seg == 4) run<1>(acc, u, wr, wc, fr, fq, O, LB);
        else if (seg == 1 || seg == 2) run<2>(acc, u, wr, wc, fr, fq, O, LB + (seg - 1) * 1024);
        else if (seg == 3) run<0>(acc, u, wr, wc, fr, fq, O, LB);
        else run<3>(acc, u, wr, wc, fr, fq, O, LB);
    }
};
struct EpiBf {
    u16* O; int ld;
    __device__ __forceinline__ bool keep(const pg8::Unit&) const { return false; }
    __device__ __forceinline__ void operator()(AccT& acc, const pg8::Unit& u, int wr, int wc, int fr, int fq) const {
        const int row0 = u.pm * 256 + wr * 64 + fr, colb = u.pn * 256 + wc * 32 + 8 * fq;
#pragma unroll
        for (int ai = 0; ai < 2; ++ai)
#pragma unroll
            for (int m = 0; m < 4; ++m)
#pragma unroll
                for (int bj = 0; bj < 2; ++bj) {
                    const f32x4 v0 = acc[ai][bj][m][0], v1 = acc[ai][bj][m][1];
                    u32x4 w; w.x = cvt_pk_bf16(v0[0], v0[1]); w.y = cvt_pk_bf16(v0[2], v0[3]); w.z = cvt_pk_bf16(v1[0], v1[1]); w.w = cvt_pk_bf16(v1[2], v1[3]);
                    *(u32x4*)(O + (size_t)(row0 + ai * 128 + m * 16) * ld + colb + bj * 128) = w;
                }
    }
};
struct EpiMerge {
    const u16* GA; const u16* GB; u16* T1;
    __device__ __forceinline__ bool keep(const pg8::Unit& u) const { return u.aux == 0; }
    __device__ __forceinline__ void operator()(AccT& acc, const pg8::Unit& u, int wr, int wc, int fr, int fq) const {
        const int row0 = u.pm * 256 + wr * 64 + fr, colb = u.pn * 256 + wc * 32 + 8 * fq;
#pragma unroll
        for (int ai = 0; ai < 2; ++ai)
#pragma unroll
            for (int m = 0; m < 4; ++m)
#pragma unroll
                for (int bj = 0; bj < 2; ++bj) {
                    const size_t idx = (size_t)(row0 + ai * 128 + m * 16) * D + colb + bj * 128;
                    const u32x4 gb = *(const u32x4*)(GB + idx);
                    float b[8] = {bflo(gb.x), bfhi(gb.x), bflo(gb.y), bfhi(gb.y), bflo(gb.z), bfhi(gb.z), bflo(gb.w), bfhi(gb.w)};
                    if (u.aux == 0) {
                        const u32x4 ga = *(const u32x4*)(GA + idx);
                        float a[8] = {bflo(ga.x), bfhi(ga.x), bflo(ga.y), bfhi(ga.y), bflo(ga.z), bfhi(ga.z), bflo(ga.w), bfhi(ga.w)};
#pragma unroll
                        for (int e = 0; e < 4; ++e) { acc[ai][bj][m][0][e] *= a[e] * __builtin_amdgcn_rcpf(fmaxf(b[e], 1e-30f)); acc[ai][bj][m][1][e] *= a[4 + e] * __builtin_amdgcn_rcpf(fmaxf(b[4 + e], 1e-30f)); }
                    } else {
                        const f32x4 v0 = acc[ai][bj][m][0], v1 = acc[ai][bj][m][1];
                        u32x4 w; w.x = cvt_pk_bf16(v0[0] * b[0], v0[1] * b[1]); w.y = cvt_pk_bf16(v0[2] * b[2], v0[3] * b[3]);
                        w.z = cvt_pk_bf16(v1[0] * b[4], v1[1] * b[5]); w.w = cvt_pk_bf16(v1[2] * b[6], v1[3] * b[7]);
                        *(u32x4*)(T1 + idx) = w;
                    }
                }
    }
};
template <bool RBF>
struct EpiRes {
    const void* R0; const void* R1; const float* gate; u16* O;
    __device__ __forceinline__ bool keep(const pg8::Unit&) const { return false; }
    __device__ __forceinline__ void operator()(AccT& acc, const pg8::Unit& u, int wr, int wc, int fr, int fq) const {
        const int row0 = u.pm * 256 + wr * 64 + fr, colb = u.pn * 256 + wc * 32 + 8 * fq;
        const float* gp = gate + (size_t)cid_of(u.pm * 256) * NMOD;
#pragma unroll
        for (int bj = 0; bj < 2; ++bj) {
            const int col = colb + bj * 128;
            const f32x4 g0 = *(const f32x4*)(gp + col), g1 = *(const f32x4*)(gp + col + 4);
#pragma unroll
            for (int ai = 0; ai < 2; ++ai)
#pragma unroll
                for (int m = 0; m < 4; ++m) {
                    const int row = row0 + ai * 128 + m * 16;
                    float x[8];
                    if (RBF) {
                        const u32x4 xr = *(const u32x4*)((const u16*)R0 + (size_t)row * D + col);
                        x[0] = bflo(xr.x); x[1] = bfhi(xr.x); x[2] = bflo(xr.y); x[3] = bfhi(xr.y); x[4] = bflo(xr.z); x[5] = bfhi(xr.z); x[6] = bflo(xr.w); x[7] = bfhi(xr.w);
                    } else {
                        const float* rp = (row < 8192 ? (const float*)R0 + (size_t)row * D : (const float*)R1 + (size_t)(row - 8192) * D) + col;
                        const f32x4 x0 = *(const f32x4*)rp, x1 = *(const f32x4*)(rp + 4);
                        x[0] = x0[0]; x[1] = x0[1]; x[2] = x0[2]; x[3] = x0[3]; x[4] = x1[0]; x[5] = x1[1]; x[6] = x1[2]; x[7] = x1[3];
                    }
                    float o[8];
#pragma unroll
                    for (int e = 0; e < 4; ++e) { o[e] = ALPHA * x[e] + g0[e] * acc[ai][bj][m][0][e]; o[4 + e] = ALPHA * x[4 + e] + g1[e] * acc[ai][bj][m][1][e]; }
                    u32x4 w; w.x = cvt_pk_bf16(o[0], o[1]); w.y = cvt_pk_bf16(o[2], o[3]); w.z = cvt_pk_bf16(o[4], o[5]); w.w = cvt_pk_bf16(o[6], o[7]);
                    *(u32x4*)(O + (size_t)row * D + col) = w;
                }
        }
    }
};
struct EpiGlu {
    u16* FF;
    __device__ __forceinline__ bool keep(const pg8::Unit&) const { return false; }
    __device__ __forceinline__ void operator()(AccT& acc, const pg8::Unit& u, int wr, int wc, int fr, int fq) const {
        const int row0 = u.pm * 256 + wr * 64 + fr, col = u.pn * 128 + wc * 32 + 8 * fq;
#pragma unroll
        for (int ai = 0; ai < 2; ++ai)
#pragma unroll
            for (int m = 0; m < 4; ++m) {
                float v[8];
#pragma unroll
                for (int e = 0; e < 4; ++e) { v[e] = silu_f(acc[ai][0][m][0][e]) * acc[ai][1][m][0][e]; v[4 + e] = silu_f(acc[ai][0][m][1][e]) * acc[ai][1][m][1][e]; }
                u32x4 w; w.x = cvt_pk_bf16(v[0], v[1]); w.y = cvt_pk_bf16(v[2], v[3]); w.z = cvt_pk_bf16(v[4], v[5]); w.w = cvt_pk_bf16(v[6], v[7]);
                *(u32x4*)(FF + (size_t)(row0 + ai * 128 + m * 16) * DFF + col) = w;
            }
    }
};

__device__ __forceinline__ void convert_tile4(LAS unsigned char* lds, const float* W, u16* WT, int K, int N, int su) {
    LAS float* tl = (LAS float*)lds;
    const int tiles_n = N >> 8, tk = su / tiles_n, tn = su - tk * tiles_n, k0 = tk * 64, n0 = tn * 256, tid = threadIdx.x;
    {
        const int kr = tid >> 6, nc = (tid & 63) * 4;
        f32x4 v[8];
#pragma unroll
        for (int it = 0; it < 8; ++it) v[it] = *(const f32x4*)(W + (size_t)(k0 + kr + 8 * it) * N + n0 + nc);
#pragma unroll
        for (int it = 0; it < 8; ++it) { LAS float* d = tl + (kr + 8 * it) * 257 + nc; d[0] = v[it][0]; d[1] = v[it][1]; d[2] = v[it][2]; d[3] = v[it][3]; }
    }
    __syncthreads();
    {
        const int nr = tid >> 1, kc = (tid & 1) * 32;
#pragma unroll
        for (int q = 0; q < 4; ++q) {
            float v[8];
#pragma unroll
            for (int e = 0; e < 8; ++e) v[e] = tl[(kc + 8 * q + e) * 257 + nr];
            u32x4 w; w.x = cvt_pk_bf16(v[0], v[1]); w.y = cvt_pk_bf16(v[2], v[3]); w.z = cvt_pk_bf16(v[4], v[5]); w.w = cvt_pk_bf16(v[6], v[7]);
            *(u32x4*)(WT + (size_t)(n0 + nr) * K + k0 + kc + 8 * q) = w;
        }
    }
    __syncthreads();
}

__device__ __forceinline__ void phase_prep(LAS unsigned char* lds, const Ctx& C) {
    const int tid = threadIdx.x;
    u16* WIN = (u16*)(C.ws + WS_WIN); u16* WPA = (u16*)(C.ws + WS_WPA); u16* WPB = (u16*)(C.ws + WS_WPB); u16* WOUT = (u16*)(C.ws + WS_WOUT);
    float* MOD = (float*)(C.ws + WS_MOD); float* LB = (float*)(C.ws + WS_LB);
    constexpr int N_CV = 640 + 64 * 3, N_MODU = 192, N_H3 = 272, N_ALL = N_CV + N_MODU + N_H3 + 1;
    for (int u = blockIdx.x; u < N_ALL; u += gridDim.x) {
        if (u < N_CV) {
            if (u < 640) convert_tile4(lds, C.in[7], WIN, 1024, NIN, u);
            else if (u < 704) convert_tile4(lds, C.in[21], WPA, 1024, 1024, u - 640);
            else if (u < 768) convert_tile4(lds, C.in[22], WPB, 1024, 1024, u - 704);
            else convert_tile4(lds, C.in[23], WOUT, 1024, 1024, u - 768);
        } else if (u < N_CV + N_MODU) {
            const int mu = u - N_CV, n0 = mu * 32, col = tid & 31, ks = tid >> 5;
            const float* cctx = C.in[4]; const float* cc = C.in[3]; const float* aw = C.in[5];
            LAS float* sc = (LAS float*)lds;
            LAS float* red = (LAS float*)(lds + 12288);
            for (int i = tid; i < 3072; i += 512) sc[i] = silu_f(i < 1024 ? cctx[i] : cc[i - 1024]);
            __syncthreads();
            float a0 = 0.f, a1 = 0.f, a2 = 0.f;
#pragma unroll
            for (int kb = 0; kb < 64; kb += 16) {
                float w[16];
#pragma unroll
                for (int kk = 0; kk < 16; ++kk) w[kk] = aw[(size_t)(ks * 64 + kb + kk) * NMOD + n0 + col];
#pragma unroll
                for (int kk = 0; kk < 16; ++kk) { const int k = ks * 64 + kb + kk; a0 += sc[k] * w[kk]; a1 += sc[1024 + k] * w[kk]; a2 += sc[2048 + k] * w[kk]; }
            }
            red[(0 * 16 + ks) * 32 + col] = a0; red[(1 * 16 + ks) * 32 + col] = a1; red[(2 * 16 + ks) * 32 + col] = a2;
            __syncthreads();
            if (tid < 96) { const int ci = tid >> 5, c2 = tid & 31; float s2 = C.in[6][n0 + c2];
#pragma unroll
                for (int k = 0; k < 16; ++k) s2 += red[(ci * 16 + k) * 32 + c2];
                MOD[ci * NMOD + n0 + c2] = s2; }
            __syncthreads();
        } else if (u < N_CV + N_MODU + N_H3) {
            const int hu = u - N_CV - N_MODU, pl = tid >> 6, j = tid & 63;
            LAS float* zs = (LAS float*)lds;
            LAS float* h1 = (LAS float*)(lds + 4096);
            LAS float* h2 = (LAS float*)(lds + 8192);
            u16* Hhi[2]; u16* Hlo[2];
#pragma unroll
            for (int pp = 0; pp < 2; ++pp) {
                const int pos = hu * 16 + pl + 8 * pp;
                const int L = pos < 256 ? 256 : 4096, t = pos < 256 ? pos : pos - 256;
                Hhi[pp] = pos < 256 ? (u16*)(C.ws + WS_H3P) + (size_t)t * 64 : (u16*)(C.ws + WS_H3S) + (size_t)t * 64;
                Hlo[pp] = Hhi[pp] + (pos < 256 ? 256 * 64 : 4096 * 64);
                if (j < 33) {
                    float z;
                    if (j == 0) z = (float)t / (float)(L - 1);
                    else {
                        const int bnd = (j - 1) & 15;
                        const float band = 1e-4f + (float)bnd * ((15.0f - 1e-4f) / 15.0f);
                        const float wpos = (float)(6.283185307179586 / (double)L) * (float)t;
                        const float ang = band * wpos;
                        z = (j <= 16) ? my_cos(ang) : -my_sin(ang);
                    }
                    zs[(pl + 8 * pp) * 40 + j] = z;
                }
            }
            __syncthreads();
            const float* fq = C.in[18];
            { float s0 = C.in[13][j], s1 = s0; const float* w1 = C.in[12];
#pragma unroll 11
              for (int i = 0; i < 33; ++i) { const float w = w1[i * 64 + j]; s0 += zs[pl * 40 + i] * w; s1 += zs[(pl + 8) * 40 + i] * w; }
              h1[pl * 64 + j] = my_sin(fq[j] * s0); h1[(pl + 8) * 64 + j] = my_sin(fq[j] * s1); }
            __syncthreads();
            { float s0 = C.in[15][j], s1 = s0; const float* w2 = C.in[14];
#pragma unroll 32
              for (int i = 0; i < 64; ++i) { const float w = w2[i * 64 + j]; s0 += h1[pl * 64 + i] * w; s1 += h1[(pl + 8) * 64 + i] * w; }
              h2[pl * 64 + j] = my_sin(fq[64 + j] * s0); h2[(pl + 8) * 64 + j] = my_sin(fq[64 + j] * s1); }
            __syncthreads();
            { float s0 = C.in[17][j], s1 = s0; const float* w3 = C.in[16];
#pragma unroll 32
              for (int i = 0; i < 64; ++i) { const float w = w3[i * 64 + j]; s0 += h2[pl * 64 + i] * w; s1 += h2[(pl + 8) * 64 + i] * w; }
              const float hv0 = my_sin(fq[128 + j] * s0), hv1 = my_sin(fq[128 + j] * s1);
              const u16 hb0 = f2bf(hv0), hb1 = f2bf(hv1);
              Hhi[0][j] = hb0; Hlo[0][j] = f2bf(hv0 - bf2f(hb0)); Hhi[1][j] = hb1; Hlo[1][j] = f2bf(hv1 - bf2f(hb1)); }
            __syncthreads();
        } else {
            const float* lg = C.in[8];
            for (int i = tid; i < 2048; i += 512) LB[i] = 1.f / (1.f + expf(lg[2048 + i] - lg[i]));
        }
    }
}

__device__ __forceinline__ void phase_modulate(const Ctx& C) {
    const int tid = threadIdx.x, c8 = (tid & 127) * 8, r4 = tid >> 7;
    const float* MOD = (const float*)(C.ws + WS_MOD); u16* HB = (u16*)(C.ws + WS_HB);
    for (int ch = blockIdx.x; ch < T / 64; ch += gridDim.x) {
        const int tok0 = ch * 64; const float* mp = MOD + (size_t)cid_of(tok0) * NMOD;
        float sh[8], sc[8];
#pragma unroll
        for (int e = 0; e < 8; ++e) { sh[e] = mp[c8 + e]; sc[e] = 1.f + mp[1024 + c8 + e]; }
#pragma unroll
        for (int hb = 0; hb < 2; ++hb) {
            f32x4 a[8], b[8];
#pragma unroll
            for (int it = 0; it < 8; ++it) { const float* xp = C.xrow(tok0 + r4 + 4 * (8 * hb + it)) + c8; a[it] = *(const f32x4*)xp; b[it] = *(const f32x4*)(xp + 4); }
#pragma unroll
            for (int it = 0; it < 8; ++it) {
                const int tok = tok0 + r4 + 4 * (8 * hb + it);
                u32x4 w; w.x = cvt_pk_bf16(a[it][0] * sc[0] + sh[0], a[it][1] * sc[1] + sh[1]); w.y = cvt_pk_bf16(a[it][2] * sc[2] + sh[2], a[it][3] * sc[3] + sh[3]);
                w.z = cvt_pk_bf16(b[it][0] * sc[4] + sh[4], b[it][1] * sc[5] + sh[5]); w.w = cvt_pk_bf16(b[it][2] * sc[6] + sh[6], b[it][3] * sc[7] + sh[7]);
                *(u32x4*)(HB + (size_t)tok * D + c8) = w;
            }
        }
    }
}

__device__ __forceinline__ float wave_sum(float v) {
#pragma unroll
    for (int o = 32; o >= 1; o >>= 1) v += __shfl_xor(v, o, 64);
    return v;
}
template <bool WITH_H>
__device__ __forceinline__ void phase_ln(const Ctx& C, const u16* U, float* Y, u16* Y16, const float* gam, const float* bet, u16* H, int scale_idx, int shift_idx) {
    const int lane = threadIdx.x & 63, wv = threadIdx.x >> 6;
    const float* MOD = (const float*)(C.ws + WS_MOD);
    for (int row0 = (blockIdx.x * 8 + wv) * 4; row0 < T; row0 += gridDim.x * 32) {
        u32x4 raw[4][2];
#pragma unroll
        for (int rr = 0; rr < 4; ++rr)
#pragma unroll
            for (int i = 0; i < 2; ++i) raw[rr][i] = *(const u32x4*)(U + (size_t)(row0 + rr) * D + 8 * lane + 512 * i);
        const float* mp = MOD + (size_t)cid_of(row0) * NMOD;
#pragma unroll
        for (int rr = 0; rr < 4; ++rr) {
            const int row = row0 + rr;
            float v[2][8];
#pragma unroll
            for (int i = 0; i < 2; ++i) { const u32x4 r = raw[rr][i];
                v[i][0] = bflo(r.x); v[i][1] = bfhi(r.x); v[i][2] = bflo(r.y); v[i][3] = bfhi(r.y); v[i][4] = bflo(r.z); v[i][5] = bfhi(r.z); v[i][6] = bflo(r.w); v[i][7] = bfhi(r.w); }
            float s = 0.f;
#pragma unroll
            for (int i = 0; i < 2; ++i)
#pragma unroll
                for (int e = 0; e < 8; ++e) s += v[i][e];
            const float mu = wave_sum(s) * (1.f / 1024.f);
            float q = 0.f;
#pragma unroll
            for (int i = 0; i < 2; ++i)
#pragma unroll
                for (int e = 0; e < 8; ++e) { const float d = v[i][e] - mu; q += d * d; }
            const float rstd = rsqrtf(wave_sum(q) * (1.f / 1024.f) + 1e-5f);
#pragma unroll
            for (int i = 0; i < 2; ++i) {
                const int col = 8 * lane + 512 * i;
                const f32x4 g0 = *(const f32x4*)(gam + col), g1 = *(const f32x4*)(gam + col + 4), b0 = *(const f32x4*)(bet + col), b1 = *(const f32x4*)(bet + col + 4);
                float y[8];
#pragma unroll
                for (int e = 0; e < 4; ++e) { y[e] = (v[i][e] - mu) * rstd * g0[e] + b0[e]; y[4 + e] = (v[i][4 + e] - mu) * rstd * g1[e] + b1[e]; }
                if (WITH_H) {
                    u32x4 w; w.x = cvt_pk_bf16(y[0], y[1]); w.y = cvt_pk_bf16(y[2], y[3]); w.z = cvt_pk_bf16(y[4], y[5]); w.w = cvt_pk_bf16(y[6], y[7]);
                    *(u32x4*)(Y16 + (size_t)row * D + col) = w;
                    const f32x4 sc0 = *(const f32x4*)(mp + scale_idx * 1024 + col), sc1 = *(const f32x4*)(mp + scale_idx * 1024 + col + 4);
                    const f32x4 sh0 = *(const f32x4*)(mp + shift_idx * 1024 + col), sh1 = *(const f32x4*)(mp + shift_idx * 1024 + col + 4);
                    float hv[8];
#pragma unroll
                    for (int e = 0; e < 4; ++e) { hv[e] = y[e] * (1.f + sc0[e]) + sh0[e]; hv[4 + e] = y[4 + e] * (1.f + sc1[e]) + sh1[e]; }
                    w.x = cvt_pk_bf16(hv[0], hv[1]); w.y = cvt_pk_bf16(hv[2], hv[3]); w.z = cvt_pk_bf16(hv[4], hv[5]); w.w = cvt_pk_bf16(hv[6], hv[7]);
                    *(u32x4*)(H + (size_t)row * D + col) = w;
                } else {
                    float* yp = Y + (size_t)row * D + col;
                    *(f32x4*)yp = (f32x4){y[0], y[1], y[2], y[3]}; *(f32x4*)(yp + 4) = (f32x4){y[4], y[5], y[6], y[7]};
                }
            }
        }
    }
}

__device__ __forceinline__ void short_conv8(const u16* row, int p0, int RL, float w0, float w1, float w2, float bias, float* out) {
    const u32x4 raw = *(const u32x4*)(row + p0);
    float u[10];
    u[1] = bflo(raw.x); u[2] = bfhi(raw.x); u[3] = bflo(raw.y); u[4] = bfhi(raw.y); u[5] = bflo(raw.z); u[6] = bfhi(raw.z); u[7] = bflo(raw.w); u[8] = bfhi(raw.w);
    u[0] = (p0 & (RL - 1)) != 0 ? bf2f(row[p0 - 1]) : 0.f;
    u[9] = ((p0 + 8) & (RL - 1)) != 0 ? bf2f(row[p0 + 8]) : 0.f;
#pragma unroll
    for (int e = 0; e < 8; ++e) out[e] = w0 * u[e] + w1 * u[e + 1] + w2 * u[e + 2] + bias;
}
__device__ __forceinline__ int zswz(int p8) { return 80 * (p8 >> 2) + 16 * (p8 & 3); }

struct ToepRaw { unsigned w0, w1, w2, w3, w4; };
__device__ __forceinline__ ToepRaw toep_load(const LAS unsigned* FRw, int mb) {
    const int dw = mb >> 1; ToepRaw r; r.w0 = FRw[dw]; r.w1 = FRw[dw + 1]; r.w2 = FRw[dw + 2]; r.w3 = FRw[dw + 3]; r.w4 = FRw[dw + 4]; return r;
}
__device__ __forceinline__ bf16x8 toep_align(const ToepRaw& r, unsigned sh) {
    u32x4 o; o.x = __builtin_amdgcn_alignbyte(r.w1, r.w0, sh); o.y = __builtin_amdgcn_alignbyte(r.w2, r.w1, sh); o.z = __builtin_amdgcn_alignbyte(r.w3, r.w2, sh); o.w = __builtin_amdgcn_alignbyte(r.w4, r.w3, sh);
    return __builtin_bit_cast(bf16x8, o);
}
__device__ __forceinline__ int zaddr(int b, int piece) { return 64 * b + 16 * (piece ^ ((b >> 2) & 3)); }
template <int M>
__device__ __forceinline__ void toep_run(f32x16 (&acc)[4], const LAS unsigned* FRw, int mb0, const LAS unsigned char* Zc, int b00, int bstep, int g, int k0, int k1) {
    const unsigned sh = (unsigned)(mb0 & 1) * 2u;
    ToepRaw r0 = toep_load(FRw, mb0 - 32 * k0), r1 = toep_load(FRw, mb0 - 32 * k0 + 16);
    bf16x8 bc[4][2];
#pragma unroll
    for (int j = 0; j < 4; ++j) if ((M >> j) & 1) { const int b = b00 + j * bstep - k0; bc[j][0] = *(const LAS bf16x8*)(Zc + zaddr(b, g)); bc[j][1] = *(const LAS bf16x8*)(Zc + zaddr(b, 2 + g)); }
#pragma unroll 1
    for (int k = k0; k <= k1; ++k) {
        const bf16x8 a0 = toep_align(r0, sh), a1 = toep_align(r1, sh);
        const int kn = k < k1 ? k + 1 : k;
        r0 = toep_load(FRw, mb0 - 32 * kn); r1 = toep_load(FRw, mb0 - 32 * kn + 16);
        bf16x8 bn[4][2];
#pragma unroll
        for (int j = 0; j < 4; ++j) if ((M >> j) & 1) { const int b = b00 + j * bstep - kn; bn[j][0] = *(const LAS bf16x8*)(Zc + zaddr(b, g)); bn[j][1] = *(const LAS bf16x8*)(Zc + zaddr(b, 2 + g)); }
#pragma unroll
        for (int j = 0; j < 4; ++j) if ((M >> j) & 1) acc[j] = mfma32(a0, bc[j][0], acc[j]);
#pragma unroll
        for (int j = 0; j < 4; ++j) if ((M >> j) & 1) acc[j] = mfma32(a1, bc[j][1], acc[j]);
#pragma unroll
        for (int j = 0; j < 4; ++j) if ((M >> j) & 1) { bc[j][0] = bn[j][0]; bc[j][1] = bn[j][1]; }
    }
}

__device__ __forceinline__ void conv_unit(LAS unsigned char* lds, const Ctx& C, int smp, int cgi) {
    const int tid = threadIdx.x, lane = tid & 63, wv = tid >> 6;
    const int L = smp ? 4096 : 256, nb = L >> 5, lnb = smp ? 7 : 3, RL = smp ? 64 : 256, utok0 = smp ? 8192 : 0, d0 = 4 * cgi;
    const int P = smp ? 31 : 7, nblk = smp ? 349 : 487, ZCH = nblk * 64, FRS = 4 * L;
    const u16* H3hi = smp ? (const u16*)(C.ws + WS_H3S) : (const u16*)(C.ws + WS_H3P);
    const u16* H3lo = H3hi + (size_t)L * 64;
    const u16* HYT = (const u16*)(C.ws + WS_R60);
    u16* OB = (u16*)C.out;
    LAS unsigned char* FRb = lds;
    LAS unsigned char* Zb = lds + 4 * FRS;
#define ZPOS(n) (P + ((n) >> lnb) * (nb + P) + ((n) & (nb - 1)))
    {
        const int n = lane & 31, hh = lane >> 5, o = n & 7, c = o & 3;
        const int gcol = (o >> 2) * 1024 + d0 + c;
        bf16x8 Bhi[4], Blo[4];
#pragma unroll
        for (int kk = 0; kk < 4; ++kk) {
            float wv8[8], wl8[8];
#pragma unroll
            for (int e = 0; e < 8; ++e) {
                const float w = (n < 8) ? C.in[19][(size_t)(16 * kk + 8 * hh + e) * 2048 + gcol] : 0.f;
                const float whi = bf2f(f2bf(w)); wv8[e] = whi; wl8[e] = w - whi;
            }
            Bhi[kk] = pack8(wv8[0], wv8[1], wv8[2], wv8[3], wv8[4], wv8[5], wv8[6], wv8[7]);
            Blo[kk] = pack8(wl8[0], wl8[1], wl8[2], wl8[3], wl8[4], wl8[5], wl8[6], wl8[7]);
        }
        const float mind = -3.0701134573253943f, maxd = -15.350567286626972f;
        const float escale = -1.4426950408889634f / (float)(L - 1);
        float delta4[4], skip4[4];
#pragma unroll
        for (int cc = 0; cc < 4; ++cc) { delta4[cc] = fabsf(mind + (maxd - mind) * ((float)(d0 + cc) / 1023.f)); skip4[cc] = C.in[20][d0 + cc]; }
        if (tid < 4) ((LAS u16*)(FRb + tid * FRS))[0] = 0;
        const int nrb = L >> 5;
        const int wvu = __builtin_amdgcn_readfirstlane(wv);
        LAS unsigned char* stg = Zb + wvu * 8192;
        const int goff0 = (lane >> 3) * 128 + 16 * ((lane & 7) ^ ((lane >> 3) & 7));
#define FILT_DMA(rbx) do { const unsigned char* gh_ = (const unsigned char*)H3hi + (size_t)(rbx) * 4096; const unsigned char* gl_ = (const unsigned char*)H3lo + (size_t)(rbx) * 4096; \
        _Pragma("unroll") for (int q = 0; q < 4; ++q) { \
            __builtin_amdgcn_global_load_lds((const unsigned*)(gh_ + goff0 + 1024 * q), (LAS unsigned*)(stg + 1024 * q), 16, 0, 0); \
            __builtin_amdgcn_global_load_lds((const unsigned*)(gl_ + goff0 + 1024 * q), (LAS unsigned*)(stg + 4096 + 1024 * q), 16, 0, 0); } } while (0)
        if (wvu < nrb) FILT_DMA(wvu);
        for (int rb = wvu; rb < nrb; rb += 8) {
            asm volatile("s_waitcnt vmcnt(0)" ::: "memory");
            bf16x8 xh[4], xl[4];
#pragma unroll
            for (int kk = 0; kk < 4; ++kk) { const int off = n * 128 + 16 * ((2 * kk + hh) ^ (n & 7));
                xh[kk] = *(const LAS bf16x8*)(stg + off); xl[kk] = *(const LAS bf16x8*)(stg + 4096 + off); }
            asm volatile("s_waitcnt lgkmcnt(0)" ::: "memory");
            if (rb + 8 < nrb) FILT_DMA(rb + 8);
            f32x16 acc;
#pragma unroll
            for (int e = 0; e < 16; ++e) acc[e] = 0.f;
#pragma unroll
            for (int kk = 0; kk < 4; ++kk) { acc = mfma32(Bhi[kk], xh[kk], acc); acc = mfma32(Bhi[kk], xl[kk], acc); acc = mfma32(Blo[kk], xh[kk], acc); }
            {
                const int tt = 32 * rb + n;
                const float tsc = (float)tt * escale;
#pragma unroll
                for (int cc = 0; cc < 4; ++cc) {
                    const float win = __builtin_amdgcn_exp2f(tsc * delta4[cc]) + 0.05f;
                    float val = acc[cc] * win;
                    LAS u16* frc = (LAS u16*)(FRb + cc * FRS);
                    if (hh == 0) { if (tt == 0) val += skip4[cc]; frc[L - tt] = f2bf(val); }
                    else if (tt > 0) frc[L + tt] = f2bf(val);
                }
            }
        }
    }
#undef FILT_DMA
    __syncthreads();
    for (int o16 = tid; o16 < ZCH / 4; o16 += 512) *(LAS u32x4*)(Zb + 16 * o16) = (u32x4){0u, 0u, 0u, 0u};
    __syncthreads();
    {
        const float* cw = C.in[10]; const float* cb = C.in[11];
#pragma unroll
        for (int it = 0; it < 8; ++it) {
            const int c = it >> 1, q = tid + 512 * (it & 1), p0 = 8 * q;
            const int c1 = 1024 + d0 + c, c2 = 2048 + d0 + c;
            float s1[8], s2[8];
            short_conv8(HYT + (size_t)c1 * T + utok0, p0, RL, cw[c1], cw[3072 + c1], cw[6144 + c1], cb[c1], s1);
            short_conv8(HYT + (size_t)c2 * T + utok0, p0, RL, cw[c2], cw[3072 + c2], cw[6144 + c2], cb[c2], s2);
            u32x4 w; w.x = cvt_pk_bf16(s1[0] * s2[0], s1[1] * s2[1]); w.y = cvt_pk_bf16(s1[2] * s2[2], s1[3] * s2[3]);
            w.z = cvt_pk_bf16(s1[4] * s2[4], s1[5] * s2[5]); w.w = cvt_pk_bf16(s1[6] * s2[6], s1[7] * s2[7]);
            *(LAS u32x4*)(Zb + c * ZCH + zaddr(ZPOS(q >> 2), q & 3)) = w;
        }
    }
    __syncthreads();
    const int ch = wv >> 1, sub = wv & 1, i = lane & 31, g = lane >> 5;
    const LAS unsigned* FRw = (const LAS unsigned*)(FRb + ch * FRS);
    const LAS unsigned char* Zc = Zb + ch * ZCH;
    f32x16 acc[4];
#pragma unroll
    for (int j = 0; j < 4; ++j)
#pragma unroll
        for (int e = 0; e < 16; ++e) acc[j][e] = 0.f;
    const int mb0 = L - i + 8 * g;
    const int b00 = ZPOS(32 * 4 * sub + i), bstep = smp ? 32 : 60;
    if (smp) {
        toep_run<1>(acc, FRw, mb0, Zc, b00, bstep, g, -127, -96);
        toep_run<3>(acc, FRw, mb0, Zc, b00, bstep, g, -95, -64);
        toep_run<7>(acc, FRw, mb0, Zc, b00, bstep, g, -63, -32);
        toep_run<15>(acc, FRw, mb0, Zc, b00, bstep, g, -31, 31);
        toep_run<14>(acc, FRw, mb0, Zc, b00, bstep, g, 32, 63);
        toep_run<12>(acc, FRw, mb0, Zc, b00, bstep, g, 64, 95);
        toep_run<8>(acc, FRw, mb0, Zc, b00, bstep, g, 96, 127);
    } else {
        toep_run<15>(acc, FRw, mb0, Zc, b00, bstep, g, -7, 7);
    }
    __syncthreads();
    {
        const float* cw = C.in[10]; const float* cb = C.in[11];
#pragma unroll
        for (int it = 0; it < 8; ++it) {
            const int c = it >> 1, q = tid + 512 * (it & 1), p0 = 8 * q, c0 = d0 + c;
            float s0[8];
            short_conv8(HYT + (size_t)c0 * T + utok0, p0, RL, cw[c0], cw[3072 + c0], cw[6144 + c0], cb[c0], s0);
            u32x4 w; w.x = cvt_pk_bf16(s0[0], s0[1]); w.y = cvt_pk_bf16(s0[2], s0[3]); w.z = cvt_pk_bf16(s0[4], s0[5]); w.w = cvt_pk_bf16(s0[6], s0[7]);
            *(LAS u32x4*)(Zb + c * ZCH + zaddr(ZPOS(q >> 2), q & 3)) = w;
        }
    }
    __syncthreads();
    {
        u16* orow = OB + (size_t)(d0 + ch) * T + utok0;
#pragma unroll
        for (int j = 0; j < 4; ++j) {
            const int n = 32 * (4 * sub + j) + i;
#pragma unroll
            for (int q = 0; q < 4; ++q) {
                const int p = n * 32 + 8 * q + 4 * g;
                const u32x2 xr = *(const LAS u32x2*)(Zc + zaddr(b00 + j * bstep, q) + 8 * g);
                u32x2 w; w.x = cvt_pk_bf16(acc[j][4 * q] * bflo(xr.x), acc[j][4 * q + 1] * bfhi(xr.x)); w.y = cvt_pk_bf16(acc[j][4 * q + 2] * bflo(xr.y), acc[j][4 * q + 3] * bfhi(xr.y));
                *(u32x2*)(orow + p) = w;
            }
        }
    }
    __syncthreads();
#undef ZPOS
}

__device__ __forceinline__ void phase_transpose_ob(LAS unsigned char* lds, const Ctx& C) {
    const u16* src = (const u16*)C.out; u16* dst = (u16*)(C.ws + WS_LFF);
    LAS u16* tl = (LAS u16*)lds;
    const int tid = threadIdx.x, r8 = tid >> 3, pc = tid & 7;
    for (int t4 = blockIdx.x; t4 < 16 * 64; t4 += gridDim.x) {
        const int c0 = (t4 >> 6) * 64, k00 = (t4 & 63) * 256;
        u32x4 v[4];
#pragma unroll
        for (int q = 0; q < 4; ++q) v[q] = *(const u32x4*)(src + (size_t)(c0 + r8) * T + k00 + 64 * q + 8 * pc);
#pragma unroll
        for (int q = 0; q < 4; ++q) { LAS unsigned* wp = (LAS unsigned*)(tl + q * 4224 + r8 * 66 + 8 * pc); wp[0] = v[q].x; wp[1] = v[q].y; wp[2] = v[q].z; wp[3] = v[q].w; }
        __syncthreads();
#pragma unroll
        for (int q = 0; q < 4; ++q) {
            unsigned o[4];
#pragma unroll
            for (int e = 0; e < 4; ++e) o[e] = (unsigned)tl[q * 4224 + (8 * pc + 2 * e) * 66 + r8] | ((unsigned)tl[q * 4224 + (8 * pc + 2 * e + 1) * 66 + r8] << 16);
            u32x4 w; w.x = o[0]; w.y = o[1]; w.z = o[2]; w.w = o[3];
            *(u32x4*)(dst + (size_t)(k00 + 64 * q + r8) * D + c0 + 8 * pc) = w;
        }
        __syncthreads();
    }
}

constexpr int SC_QIN = 0, SC_KIN = 8704, SC_KST = 17408, SC_VT = 27648, SC_DEC = 37888, SC_BUF = 38400, SC_HALF = 2 * SC_BUF;

__device__ __forceinline__ void scan_unit(LAS unsigned char* lds_all, const Ctx& C, int pseq, int h, int mode) {
    const int tid = threadIdx.x, dir = tid >> 8, lane = tid & 63, beta = (tid >> 6) & 3, r = lane & 31, hh = lane >> 5;
    const bool want_out = (mode != 1);
    LAS unsigned char* ldsh = lds_all + dir * SC_HALF;
    const u16* Q = (const u16*)(C.ws + WS_Q); const u16* V = (const u16*)(C.ws + WS_V);
    u16* LF = (u16*)(C.ws + (dir ? WS_LFB : WS_LFF));
    float* SEGF = (float*)(C.ws + WS_HB); float* SEGD = (float*)(C.ws + WS_SEGD);
    const int tok_base = pseq * 256, col0 = h * 128;
    const int a_p = 32 * beta + r, rh = hh;

    f32x16 S[4];
#pragma unroll
    for (int al = 0; al < 4; ++al)
#pragma unroll
        for (int e = 0; e < 16; ++e) S[al][e] = 0.f;
    if (mode == 2) {
        const float* s0 = SEGF + (size_t)(((pseq - 32) * 8 + h) * 2 + dir) * 16384;
#pragma unroll
        for (int al = 0; al < 4; ++al)
#pragma unroll
            for (int e = 0; e < 16; ++e) S[al][e] = s0[(32 * al + rowmap(e, hh)) * 128 + 32 * beta + r];
    }
    float dsum = 0.f;
    u16 rl[16], rq[16] = {}, rv[16];
    const u16* Qb = Q + (size_t)tok_base * D + col0; const u16* Vb = V + (size_t)tok_base * D + col0; u16* LFb = LF + (size_t)tok_base * D + col0;
    const int stepD = dir ? -D : D, prow0 = dir ? 31 - 16 * rh : 16 * rh;
#define SCAN_LOAD(nc) do { const int cidx_ = dir ? 7 - (nc) : (nc); const int o_ = (32 * cidx_ + prow0) * D + a_p; \
        _Pragma("unroll") for (int pp = 0; pp < 16; ++pp) { rl[pp] = LFb[(unsigned)(o_ + pp * stepD)]; if (want_out) rq[pp] = Qb[(unsigned)(o_ + pp * stepD)]; rv[pp] = Vb[(unsigned)(o_ + pp * stepD)]; } } while (0)
#define SCAN_PREP(bufp) do { LAS unsigned char* lb_ = (bufp); float b_[16]; float run_ = 0.f; \
        _Pragma("unroll") for (int pp = 0; pp < 16; ++pp) { run_ += (float)__builtin_bit_cast(_Float16, rl[pp]); b_[pp] = run_; } \
        const float other_ = __shfl_xor(run_, 32, 64), blast_ = run_ + other_, dect_ = __expf(blast_), badd_ = rh ? other_ : 0.f; \
        float kst_[16]; \
        _Pragma("unroll") for (int pp = 0; pp < 16; ++pp) { \
            const float kk_ = 1.f - __expf((float)__builtin_bit_cast(_Float16, rl[pp])); \
            const float eb_ = __expf(b_[pp] + badd_), kin_ = kk_ * __builtin_amdgcn_rcpf(eb_); const int p_ = 16 * rh + pp; \
            if (want_out) { *(LAS u16*)(lb_ + SC_QIN + p_ * 272 + a_p * 2) = f2bf(bf2f(rq[pp]) * eb_); \
                            *(LAS u16*)(lb_ + SC_KIN + p_ * 272 + a_p * 2) = f2bf(kin_); } \
            kst_[pp] = kin_ * dect_; } \
        u32x4 w0_, w1_; \
        w0_.x = cvt_pk_bf16(kst_[0], kst_[1]); w0_.y = cvt_pk_bf16(kst_[2], kst_[3]); w0_.z = cvt_pk_bf16(kst_[4], kst_[5]); w0_.w = cvt_pk_bf16(kst_[6], kst_[7]); \
        w1_.x = cvt_pk_bf16(kst_[8], kst_[9]); w1_.y = cvt_pk_bf16(kst_[10], kst_[11]); w1_.z = cvt_pk_bf16(kst_[12], kst_[13]); w1_.w = cvt_pk_bf16(kst_[14], kst_[15]); \
        *(LAS u32x4*)(lb_ + SC_KST + a_p * 80 + 32 * rh) = w0_; *(LAS u32x4*)(lb_ + SC_KST + a_p * 80 + 32 * rh + 16) = w1_; \
        w0_.x = rv[0] | ((unsigned)rv[1] << 16); w0_.y = rv[2] | ((unsigned)rv[3] << 16); w0_.z = rv[4] | ((unsigned)rv[5] << 16); w0_.w = rv[6] | ((unsigned)rv[7] << 16); \
        w1_.x = rv[8] | ((unsigned)rv[9] << 16); w1_.y = rv[10] | ((unsigned)rv[11] << 16); w1_.z = rv[12] | ((unsigned)rv[13] << 16); w1_.w = rv[14] | ((unsigned)rv[15] << 16); \
        *(LAS u32x4*)(lb_ + SC_VT + a_p * 80 + 32 * rh) = w0_; *(LAS u32x4*)(lb_ + SC_VT + a_p * 80 + 32 * rh + 16) = w1_; \
        if (rh == 0) { ((LAS float*)(lb_ + SC_DEC))[a_p] = dect_; dsum += blast_; } } while (0)
    SCAN_LOAD(0);
    SCAN_PREP(ldsh);
    __syncthreads();
    for (int nchunk = 0; nchunk < 8; ++nchunk) {
        const int cidx = dir ? 7 - nchunk : nchunk;
        LAS unsigned char* lds = ldsh + (nchunk & 1) * SC_BUF;
        if (nchunk < 7) SCAN_LOAD(nchunk + 1);
        if (want_out) {
            f32x16 accP;
#pragma unroll
            for (int e = 0; e < 16; ++e) accP[e] = 0.f;
#pragma unroll
            for (int kk = 0; kk < 8; ++kk) {
                const bf16x8 A = *(const LAS bf16x8*)(lds + SC_KIN + r * 272 + 32 * kk + 16 * hh);
                const bf16x8 B = *(const LAS bf16x8*)(lds + SC_QIN + r * 272 + 32 * kk + 16 * hh);
                accP = mfma32(A, B, accP);
            }
#pragma unroll
            for (int e = 0; e < 16; ++e) if (rowmap(e, hh) > r) accP[e] = 0.f;
            f32x16 acco;
#pragma unroll
            for (int e = 0; e < 16; ++e) acco[e] = 0.f;
#pragma unroll
            for (int st = 0; st < 2; ++st) {
                const bf16x8 Pf = pack8(accP[8 * st], accP[8 * st + 1], accP[8 * st + 2], accP[8 * st + 3], accP[8 * st + 4], accP[8 * st + 5], accP[8 * st + 6], accP[8 * st + 7]);
                const bf16x4 lo = *(const LAS bf16x4*)(lds + SC_VT + (32 * beta + r) * 80 + 32 * st + 8 * hh);
                const bf16x4 hi = *(const LAS bf16x4*)(lds + SC_VT + (32 * beta + r) * 80 + 32 * st + 16 + 8 * hh);
                const bf16x8 Bv = (bf16x8){lo[0], lo[1], lo[2], lo[3], hi[0], hi[1], hi[2], hi[3]};
                acco = mfma32(Pf, Bv, acco);
            }
#pragma unroll
            for (int al = 0; al < 4; ++al)
#pragma unroll
                for (int st = 0; st < 2; ++st) {
                    const bf16x4 lo = *(const LAS bf16x4*)(lds + SC_QIN + r * 272 + (32 * al + 16 * st + 4 * hh) * 2);
                    const bf16x4 hi = *(const LAS bf16x4*)(lds + SC_QIN + r * 272 + (32 * al + 16 * st + 8 + 4 * hh) * 2);
                    const bf16x8 Aq = (bf16x8){lo[0], lo[1], lo[2], lo[3], hi[0], hi[1], hi[2], hi[3]};
                    const bf16x8 Bs = pack8(S[al][8 * st], S[al][8 * st + 1], S[al][8 * st + 2], S[al][8 * st + 3], S[al][8 * st + 4], S[al][8 * st + 5], S[al][8 * st + 6], S[al][8 * st + 7]);
                    acco = mfma32(Aq, Bs, acco);
                }
            { const int ob = (32 * cidx + (dir ? 31 - 4 * hh : 4 * hh)) * D + 32 * beta + r;
#pragma unroll
              for (int e = 0; e < 16; ++e) LFb[(unsigned)(ob + ((e & 3) + 8 * (e >> 2)) * stepD)] = f2bf(acco[e]); }
        }
#pragma unroll
        for (int al = 0; al < 4; ++al) {
#pragma unroll
            for (int q = 0; q < 4; ++q) {
                const f32x4 d4 = *(const LAS f32x4*)(lds + SC_DEC + (32 * al + 8 * q + 4 * hh) * 4);
#pragma unroll
                for (int e = 0; e < 4; ++e) S[al][4 * q + e] *= d4[e];
            }
#pragma unroll
            for (int st = 0; st < 2; ++st) {
                const bf16x8 A = *(const LAS bf16x8*)(lds + SC_KST + (32 * al + r) * 80 + 32 * st + 16 * hh);
                const bf16x8 B = *(const LAS bf16x8*)(lds + SC_VT + (32 * beta + r) * 80 + 32 * st + 16 * hh);
                S[al] = mfma32(A, B, S[al]);
            }
        }
        if (nchunk < 7) SCAN_PREP(ldsh + ((nchunk + 1) & 1) * SC_BUF);
        __syncthreads();
    }
#undef SCAN_LOAD
#undef SCAN_PREP
    if (mode == 0) {
        float* ns = C.out + (size_t)T * D + (size_t)((pseq * 2 + dir) * 8 + h) * 16384;
#pragma unroll
        for (int al = 0; al < 4; ++al)
#pragma unroll
            for (int e = 0; e < 16; ++e) ns[(32 * al + rowmap(e, hh)) * 128 + 32 * beta + r] = S[al][e];
    } else if (mode == 1) {
        const int seg = pseq - 32;
        float* Fp = SEGF + (size_t)((seg * 8 + h) * 2 + dir) * 16384;
#pragma unroll
        for (int al = 0; al < 4; ++al)
#pragma unroll
            for (int e = 0; e < 16; ++e) Fp[(32 * al + rowmap(e, hh)) * 128 + 32 * beta + r] = S[al][e];
        if (rh == 0) SEGD[(size_t)((seg * 8 + h) * 2 + dir) * 128 + a_p] = __expf(dsum);
    }
    if (want_out) {
        __syncthreads();
        const u16* OF = (const u16*)(C.ws + WS_LFF); const u16* OBk = (const u16*)(C.ws + WS_LFB); u16* G = (u16*)(C.ws + WS_G);
        const int l16 = tid & 15, trow = tid >> 4, v0 = 8 * l16;
        const f32x4 nw0 = *(const f32x4*)(C.in[9] + v0), nw1 = *(const f32x4*)(C.in[9] + v0 + 4);
        const float nw[8] = {nw0[0], nw0[1], nw0[2], nw0[3], nw1[0], nw1[1], nw1[2], nw1[3]};
#pragma unroll
        for (int ib = 0; ib < 2; ++ib) {
            u32x4 fv[4], bv[4], gv4[4];
#pragma unroll
            for (int it = 0; it < 4; ++it) { const size_t idx = (size_t)(tok_base + trow + 32 * (4 * ib + it)) * D + col0 + v0;
                fv[it] = *(const u32x4*)(OF + idx); bv[it] = *(const u32x4*)(OBk + idx); gv4[it] = *(const u32x4*)(G + idx); }
#pragma unroll
            for (int it = 0; it < 4; ++it) {
                const size_t idx = (size_t)(tok_base + trow + 32 * (4 * ib + it)) * D + col0 + v0;
                const u32x4 f = fv[it], bk = bv[it], gg = gv4[it];
                float o[8] = {bflo(f.x) + bflo(bk.x), bfhi(f.x) + bfhi(bk.x), bflo(f.y) + bflo(bk.y), bfhi(f.y) + bfhi(bk.y),
                              bflo(f.z) + bflo(bk.z), bfhi(f.z) + bfhi(bk.z), bflo(f.w) + bflo(bk.w), bfhi(f.w) + bfhi(bk.w)};
                const float gv[8] = {bflo(gg.x), bfhi(gg.x), bflo(gg.y), bfhi(gg.y), bflo(gg.z), bfhi(gg.z), bflo(gg.w), bfhi(gg.w)};
                float ss = 0.f;
#pragma unroll
                for (int e = 0; e < 8; ++e) ss += o[e] * o[e];
#pragma unroll
                for (int of = 8; of >= 1; of >>= 1) ss += __shfl_xor(ss, of, 64);
                const float rinv = rsqrtf(ss * (1.f / 128.f) + 1e-6f);
#pragma unroll
                for (int e = 0; e < 8; ++e) o[e] = o[e] * rinv * nw[e] * gv[e];
                u32x4 w; w.x = cvt_pk_bf16(o[0], o[1]); w.y = cvt_pk_bf16(o[2], o[3]); w.z = cvt_pk_bf16(o[4], o[5]); w.w = cvt_pk_bf16(o[6], o[7]);
                *(u32x4*)(G + idx) = w;
            }
        }
    }
    __syncthreads();
}

__device__ __forceinline__ void phase_prefix(const Ctx& C) {
    float* SEGF = (float*)(C.ws + WS_HB); const float* SEGD = (const float*)(C.ws + WS_SEGD);
    for (int v = blockIdx.x * 512 + threadIdx.x; v < 32 * 4096; v += gridDim.x * 512) {
        const int chain = v >> 12, e4 = v & 4095, a = e4 >> 5;
        const int sq = chain >> 4, h = (chain >> 1) & 7, dir = chain & 1;
        f32x4 s = *(const f32x4*)(C.in[2] + (size_t)((sq * 2 + dir) * 8 + h) * 16384 + 4 * e4);
#pragma unroll 8
        for (int i = 0; i < 16; ++i) {
            const int seg = sq * 16 + (dir ? 15 - i : i);
            float* fp = SEGF + (size_t)((seg * 8 + h) * 2 + dir) * 16384 + 4 * e4;
            const f32x4 f = *(const f32x4*)fp; const float d = SEGD[(size_t)((seg * 8 + h) * 2 + dir) * 128 + a];
            *(f32x4*)fp = s;
            s = d * s + f;
        }
    }
}

#define XB_TMO      128
#define XB_XCNT(j)  (256  + 64 * (j))
#define XB_XSUB(j)  (1280 + 64 * (j))
#define XB_XGEN(j)  (2304 + 64 * (j))
#define XB_TOP      3328
#define XB_TOPGEN   3392
#define XCD_BAR_WORDS 3456
#define XB_SPIN_CAP (1u << 18)
__device__ __forceinline__ unsigned xb_ld(unsigned* p)              { return __hip_atomic_load(p, __ATOMIC_RELAXED, __HIP_MEMORY_SCOPE_AGENT); }
__device__ __forceinline__ unsigned xb_add(unsigned* p, unsigned v) { return __hip_atomic_fetch_add(p, v, __ATOMIC_RELAXED, __HIP_MEMORY_SCOPE_AGENT); }
__device__ __forceinline__ unsigned xb_xcc_id() { return (unsigned)__builtin_amdgcn_s_getreg((3 << 11) | 20) & 0xFu; }
#define XB_SPIN(cond, bar) do { unsigned _sp = 0; while (cond) { __builtin_amdgcn_s_sleep(1); \
    if ((++_sp & 255u) == 0u) { if (xb_ld(&(bar)[XB_TMO])) break; if (_sp > XB_SPIN_CAP) { atomicAdd(&(bar)[XB_TMO], 1u); break; } } } } while (0)
struct XcdBarrier { unsigned* bar; unsigned x; volatile LAS unsigned* st; };
__device__ __forceinline__ XcdBarrier xcd_barrier_post(unsigned* bar, volatile LAS unsigned* st) {
    XcdBarrier b; b.bar = bar; b.x = xb_xcc_id(); b.st = st;
    if (threadIdx.x == 0) (void)xb_add(&bar[XB_XCNT(b.x)], 1u);
    return b;
}
__device__ __forceinline__ void xcd_barrier_complete(unsigned* bar, unsigned x, unsigned& nloc, unsigned& nx) {
    const unsigned G = gridDim.x * gridDim.y * gridDim.z;
    unsigned sum, cnt, mine, sp = 0u;
    for (;;) {
        sum = 0u; cnt = 0u; mine = 0u;
#pragma unroll
        for (unsigned j = 0; j < 16; ++j) { const unsigned c = xb_ld(&bar[XB_XCNT(j)]); sum += c; cnt += (c > 0u) ? 1u : 0u; mine = (j == x) ? c : mine; }
        if (sum == G) break;
        __builtin_amdgcn_s_sleep(1);
        if ((++sp & 255u) == 0u) { if (xb_ld(&bar[XB_TMO])) break; if (sp > XB_SPIN_CAP) { atomicAdd(&bar[XB_TMO], 1u); break; } }
    }
    nloc = mine > 0u ? mine : 1u; nx = cnt > 0u ? cnt : 1u;
}
__device__ __forceinline__ void xcd_barrier(const XcdBarrier& b) {
    asm volatile("s_waitcnt vmcnt(0)" ::: "memory");
    __syncthreads();
    if (threadIdx.x == 0) {
        unsigned* bar = b.bar;
        __builtin_amdgcn_s_waitcnt(0);
        unsigned nloc = b.st[0], nx = b.st[1];
        if (nloc == 0u) { xcd_barrier_complete(bar, b.x, nloc, nx); b.st[0] = nloc; b.st[1] = nx; }
        const unsigned old = xb_add(&bar[XB_XSUB(b.x)], 1u);
        const unsigned gen = old / nloc;
        if (old + 1u == (gen + 1u) * nloc) {
            __builtin_amdgcn_fence(__ATOMIC_RELEASE, "agent");
            asm volatile("s_waitcnt vmcnt(0)" ::: "memory");
            const unsigned og = xb_add(&bar[XB_TOP], 1u);
            const unsigned tg = og / nx;
            if (og + 1u == (tg + 1u) * nx) xb_add(&bar[XB_TOPGEN], 1u);
            else XB_SPIN(xb_ld(&bar[XB_TOPGEN]) == tg, bar);
            __builtin_amdgcn_fence(__ATOMIC_ACQUIRE, "agent");
            xb_add(&bar[XB_XGEN(b.x)], 1u);
            asm volatile("s_waitcnt vmcnt(0)" ::: "memory");
        } else {
            XB_SPIN(xb_ld(&bar[XB_XGEN(b.x)]) == gen, bar);
            __builtin_amdgcn_fence(__ATOMIC_ACQUIRE, "agent");
            asm volatile("s_waitcnt vmcnt(0)" ::: "memory");
        }
    }
    __syncthreads();
}

constexpr int N_PHASES = 15;
__global__ void __launch_bounds__(512, 2) mega_fwd(Params P) {
    extern __shared__ __attribute__((aligned(16))) unsigned char lds_raw[];
    LAS unsigned char* lds = (LAS unsigned char*)lds_raw;
    cg::grid_group grid = cg::this_grid();
    Ctx C;
#pragma unroll
    for (int i = 0; i < 30; ++i) C.in[i] = P.in[i];
    C.out = P.out; C.ws = P.ws;
    unsigned char* ws = P.ws;
    const int lo = P.ph_lo, hi = P.ph_hi;
    const int G = gridDim.x, bid = blockIdx.x;
    volatile LAS unsigned* xbw = (volatile LAS unsigned*)(lds + LDS_XB_OFF);
    if (threadIdx.x < 4) xbw[threadIdx.x] = 0u;
    __syncthreads();
    XcdBarrier xbar = xcd_barrier_post((unsigned*)(ws + WS_BAR), xbw);
#ifndef PHM
#define PHM 0x7fff
#endif
#define IN(k) (((PHM >> (k)) & 1) && lo <= (k) && (k) < hi)
#ifndef REPEAT_MASK
#define REPEAT_MASK 0
#endif
#define NREP(k) ((((REPEAT_MASK) >> (k)) & 1) ? 2 : 1)
#define SEAM(k) do { if (IN(k) && IN((k) + 1)) { if (hi > 1000) grid.sync(); else xcd_barrier(xbar); } } while (0)

    if (IN(0)) for (int rep_ = 0; rep_ < NREP(0); ++rep_) { phase_prep(lds, C); }
    SEAM(0);
    if (IN(1)) for (int rep_ = 0; rep_ < NREP(1); ++rep_) { phase_modulate(C); }
    SEAM(1);
    if (IN(2)) for (int rep_ = 0; rep_ < NREP(2); ++rep_) {
        pg8::Gemm g{1024, (size_t)128 * 1024 * 2, (size_t)128 * 1024 * 2};
        pg8::Sched S{}; S.nM = 12; S.nN = 64; S.nwg = 768; S.G = G; S.c = bid; S.kind = 0;
        S.A = (const char*)(ws + WS_WIN) + (size_t)5120 * 2048; S.B = (const char*)(ws + WS_HB); S.tsA = (size_t)256 * 2048; S.tsB = (size_t)256 * 2048;
        EpiBf E{(u16*)(ws + WS_R60), T};
        pg8::gemm_phase<EpiBf>(lds, g, S, E);
    }
    SEAM(2);
    if (IN(3)) for (int rep_ = 0; rep_ < NREP(3); ++rep_) { for (int u = bid; u < 512; u += G) conv_unit(lds, C, u >> 8, u & 255); }
    SEAM(3);
    if (IN(4)) for (int rep_ = 0; rep_ < NREP(4); ++rep_) {
        pg8::Gemm g{1024, (size_t)128 * 1024 * 2, (size_t)128 * 1024 * 2};
        pg8::Sched S{}; S.nM = 64; S.nN = 28; S.nwg = 1792; S.G = G; S.c = bid; S.kind = 1;
        S.A = (const char*)(ws + WS_HB); S.B = (const char*)(ws + WS_WIN); S.tsA = (size_t)256 * 2048; S.tsB = 0;
        EpiIn E; E.out[0] = (u16*)(ws + WS_Q); E.out[1] = (u16*)(ws + WS_LFF); E.out[2] = (u16*)(ws + WS_LFB); E.out[3] = (u16*)(ws + WS_V);
        E.out[4] = (u16*)(ws + WS_G); E.out[5] = (u16*)(ws + WS_GA); E.out[6] = (u16*)((unsigned char*)P.out + 32 * MiB); E.LB = (const float*)(ws + WS_LB);
        pg8::gemm_phase<EpiIn>(lds, g, S, E);
    }
    SEAM(4);
    if (IN(5)) for (int rep_ = 0; rep_ < NREP(5); ++rep_) {
        for (int u = bid; u < 512; u += G) { if (u < 256) scan_unit(lds, C, u >> 3, u & 7, 0); else scan_unit(lds, C, 32 + ((u - 256) >> 3), u & 7, 1); }
    }
    SEAM(5);
    if (IN(6)) { phase_prefix(C); }
    SEAM(6);
    if (IN(7)) for (int rep_ = 0; rep_ < NREP(7); ++rep_) { for (int u = bid; u < 256; u += G) scan_unit(lds, C, 32 + (u >> 3), u & 7, 2); }
    SEAM(7);
    if (IN(8)) for (int rep_ = 0; rep_ < NREP(8); ++rep_) { phase_transpose_ob(lds, C); }
    SEAM(8);
    if (IN(9)) for (int rep_ = 0; rep_ < NREP(9); ++rep_) {
        pg8::Gemm g{1024, (size_t)128 * 1024 * 2, (size_t)128 * 1024 * 2};
        pg8::Sched S{}; S.nM = 64; S.nN = 4; S.nwg = 256; S.G = G; S.c = bid; S.kind = 2;
        S.A = (const char*)(ws + WS_G); S.A2 = (const char*)(ws + WS_LFF); S.B = (const char*)(ws + WS_WPA); S.B2 = (const char*)(ws + WS_WPB); S.tsA = (size_t)256 * 2048; S.tsB = (size_t)256 * 2048;
        EpiMerge E{(const u16*)(ws + WS_GA), (const u16*)((unsigned char*)P.out + 32 * MiB), (u16*)(ws + WS_T1)};
        pg8::gemm_phase<EpiMerge>(lds, g, S, E);
    }
    SEAM(9);
    if (IN(10)) for (int rep_ = 0; rep_ < NREP(10); ++rep_) {
        pg8::Gemm g{1024, (size_t)128 * 1024 * 2, (size_t)128 * 1024 * 2};
        pg8::Sched S{}; S.nM = 64; S.nN = 4; S.nwg = 256; S.G = G; S.c = bid; S.kind = 0;
        S.A = (const char*)(ws + WS_T1); S.B = (const char*)(ws + WS_WOUT); S.tsA = (size_t)256 * 2048; S.tsB = (size_t)256 * 2048;
        EpiRes<false> E{P.in[0], P.in[1], (const float*)(ws + WS_MOD) + 2 * 1024, (u16*)(ws + WS_U1)};
        pg8::gemm_phase<EpiRes<false>>(lds, g, S, E);
    }
    SEAM(10);
    if (IN(11)) for (int rep_ = 0; rep_ < NREP(11); ++rep_) {
        phase_ln<true>(C, (const u16*)(ws + WS_U1), nullptr, (u16*)(ws + WS_X1), P.in[24], P.in[25], (u16*)(ws + WS_HB), 4, 3);
        __syncthreads();
        for (int u = bid; u < 352; u += G) convert_tile4(lds, P.in[26], (u16*)(ws + WS_WFIN), 1024, 2 * DFF, u);
        if (G != 256) for (int u = bid; u < 176; u += G) convert_tile4(lds, P.in[27], (u16*)(ws + WS_WFOUT), DFF, 1024, u);
    }
    SEAM(11);
    if (IN(12)) for (int rep_ = 0; rep_ < NREP(12); ++rep_) {
        pg8::Gemm g{1024, (size_t)128 * 1024 * 2, (size_t)DFF * 1024 * 2};
        pg8::Sched S{}; S.nM = 64; S.nN = 22; S.nwg = 1408; S.G = G; S.c = bid; S.kind = 0;
        S.A = (const char*)(ws + WS_HB); S.B = (const char*)(ws + WS_WFIN); S.tsA = (size_t)256 * 2048; S.tsB = (size_t)128 * 2048;
        EpiGlu E{(u16*)(ws + WS_FF)};
        pg8::gemm_phase<EpiGlu>(lds, g, S, E);
        if (G == 256 && bid >= 128) for (int u = bid - 128; u < 176; u += 128) convert_tile4(lds, P.in[27], (u16*)(ws + WS_WFOUT), DFF, 1024, u);
    }
    SEAM(12);
    if (IN(13)) for (int rep_ = 0; rep_ < NREP(13); ++rep_) {
        pg8::Gemm g{DFF, (size_t)128 * DFF * 2, (size_t)128 * DFF * 2};
        pg8::Sched S{}; S.nM = 64; S.nN = 4; S.nwg = 256; S.G = G; S.c = bid; S.kind = 0;
        S.A = (const char*)(ws + WS_FF); S.B = (const char*)(ws + WS_WFOUT); S.tsA = (size_t)256 * DFF * 2; S.tsB = (size_t)256 * DFF * 2;
        EpiRes<true> E{(const void*)(ws + WS_X1), nullptr, (const float*)(ws + WS_MOD) + 5 * 1024, (u16*)(ws + WS_HB)};
        pg8::gemm_phase<EpiRes<true>>(lds, g, S, E);
    }
    SEAM(13);
    if (IN(14)) for (int rep_ = 0; rep_ < NREP(14); ++rep_) { phase_ln<false>(C, (const u16*)(ws + WS_HB), P.out, nullptr, P.in[28], P.in[29], nullptr, 0, 0); }
#ifdef DEBUG_SANITIZE
    if (lo == 15) {
        const unsigned* w32 = (const unsigned*)P.ws; unsigned* o32 = (unsigned*)P.out;
        const size_t n = (size_t)T * D, nall = n + 8388608;
        for (size_t i = (size_t)bid * 512 + threadIdx.x; i < nall; i += (size_t)G * 512) {
            unsigned w = o32[i];
#ifdef DEBUG_FOLD
            if (i < n) w ^= w32[i] ^ w32[i + n] ^ w32[i + 2 * n] ^ w32[i + 3 * n];
#endif
            float v = __uint_as_float(w); if (!(fabsf(v) < 1e30f)) v = 0.f;
            P.out[i] = v;
        }
    }
#endif
#undef IN
#undef SEAM
}

extern "C" void kernel_launch(void* const* d_in, const int* in_sizes, int n_in, void* d_out, int out_size, void* d_ws, size_t ws_size, hipStream_t stream) {
    static int grid_blocks = 0;
    if (!grid_blocks) {
        int dev = 0, cus = 0, per_cu = 0;
        hipGetDevice(&dev);
        hipDeviceGetAttribute(&cus, hipDeviceAttributeMultiprocessorCount, dev);
        hipFuncSetAttribute((const void*)mega_fwd, hipFuncAttributeMaxDynamicSharedMemorySize, LDS_BYTES);
        hipOccupancyMaxActiveBlocksPerMultiprocessor(&per_cu, (const void*)mega_fwd, 512, LDS_BYTES);
        if (per_cu < 1) { fprintf(stderr, "occupancy query says %d blocks per CU\n", per_cu); per_cu = 1; }
        if (per_cu > 1) per_cu = 1;
        grid_blocks = cus * per_cu;
        (void)hipGetLastError();
    }
    Params p{};
    for (int i = 0; i < 30; ++i) p.in[i] = (const float*)d_in[i];
    p.out = (float*)d_out; p.ws = (unsigned char*)d_ws;
#if SPLIT_LAUNCH
#ifndef PH_END
#define PH_END N_PHASES
#endif
#ifdef DEBUG_SANITIZE
    const int n_launch = 16;
#else
    const int n_launch = PH_END;
#endif
    for (int ph = 0; ph < n_launch; ++ph) {
        if (ph >= PH_END && ph < 15) continue;
        p.ph_lo = ph; p.ph_hi = ph + 1;
        hipLaunchKernelGGL(mega_fwd, dim3(grid_blocks), dim3(512), LDS_BYTES, stream, p);
    }
#else
    p.ph_lo = 0; p.ph_hi = N_PHASES;
    (void)hipMemsetAsync((char*)d_ws + WS_BAR, 0, XCD_BAR_WORDS * sizeof(unsigned), stream);
    void* args[] = {&p};
    hipError_t e = hipLaunchCooperativeKernel((const void*)mega_fwd, dim3(grid_blocks), dim3(512), args, LDS_BYTES, stream);
    if (e != hipSuccess) fprintf(stderr, "cooperative launch failed: %s (grid %d)\n", hipGetErrorString(e), grid_blocks);
#endif
}
```

```cpp
#include <hip/hip_runtime.h>
#include <hip/hip_cooperative_groups.h>
#include <cstdio>
namespace cg = cooperative_groups;

#define CONV_REP_MAIN 1
#ifndef SPLIT_LAUNCH
#define SPLIT_LAUNCH 0
#endif

#define LAS __attribute__((address_space(3)))
typedef unsigned short u16;
typedef short bf16x8 __attribute__((ext_vector_type(8)));
typedef short bf16x4 __attribute__((ext_vector_type(4)));
typedef float f32x4 __attribute__((ext_vector_type(4)));
typedef float f32x16 __attribute__((ext_vector_type(16)));
typedef unsigned u32x4 __attribute__((ext_vector_type(4)));
typedef unsigned u32x2 __attribute__((ext_vector_type(2)));
typedef _Float16 h16x2 __attribute__((ext_vector_type(2)));

constexpr int T = 16384, D = 1024, NIN = 10240, DFF = 2816, NMOD = 6144;
constexpr size_t MiB = 1u << 20;
constexpr int LDS_BYTES = 155648 + 64;
constexpr int LDS_XB_OFF = 155648;
constexpr float ALPHA = 1.189207115002721f;

constexpr size_t WS_WIN = 0, WS_WPA = 20 * MiB, WS_WPB = 22 * MiB, WS_WOUT = 24 * MiB;
constexpr size_t WS_MISC = 26 * MiB;
constexpr size_t WS_MOD = WS_MISC, WS_LB = WS_MISC + 128 * 1024, WS_H3P = WS_MISC + 256 * 1024, WS_H3S = WS_MISC + 512 * 1024, WS_SEGD = WS_MISC + 1536 * 1024, WS_BAR = WS_MISC + 1792 * 1024;
constexpr size_t WS_HB = 28 * MiB;
constexpr size_t WS_R60 = 60 * MiB;
constexpr size_t WS_Q = 60 * MiB, WS_LFF = 92 * MiB, WS_LFB = 124 * MiB, WS_V = 156 * MiB, WS_G = 188 * MiB, WS_GA = 220 * MiB;
constexpr size_t WS_T1 = 60 * MiB, WS_U1 = 92 * MiB, WS_X1 = 156 * MiB, WS_FF = 60 * MiB, WS_WFIN = 220 * MiB, WS_WFOUT = 232 * MiB;

struct Params { const float* in[30]; float* out; unsigned char* ws; int ph_lo, ph_hi; };

struct Ctx {
    const float* in[30]; float* out; unsigned char* ws;
    __device__ __forceinline__ const float* xrow(int tok) const { return tok < 8192 ? in[0] + (size_t)tok * D : in[1] + (size_t)(tok - 8192) * D; }
};
__device__ __forceinline__ int cid_of(int tok) { return tok < 8192 ? 0 : 1 + ((tok - 8192) >> 12); }

typedef __bf16 bf16v2 __attribute__((ext_vector_type(2)));
typedef float f32x2 __attribute__((ext_vector_type(2)));
__device__ __forceinline__ unsigned cvt_pk_bf16(float lo, float hi) { f32x2 v = {lo, hi}; bf16v2 b = __builtin_convertvector(v, bf16v2); return __builtin_bit_cast(unsigned, b); }
__device__ __forceinline__ float bf2f(u16 b) { return __uint_as_float(((unsigned)b) << 16); }
__device__ __forceinline__ float bflo(unsigned w) { return __uint_as_float(w << 16); }
__device__ __forceinline__ float bfhi(unsigned w) { return __uint_as_float(w & 0xffff0000u); }
__device__ __forceinline__ u16 f2bf(float f) { return (u16)(cvt_pk_bf16(f, 0.f) & 0xffffu); }
__device__ __forceinline__ float sigmoid_f(float x) { return __builtin_amdgcn_rcpf(1.f + __expf(-x)); }
__device__ __forceinline__ float silu_f(float x) { return x * __builtin_amdgcn_rcpf(1.f + __expf(-x)); }
__device__ __forceinline__ float red2pi(float x) { const float k = rintf(x * 0.15915494309189535f); float r = fmaf(-k, 6.2831854820251465f, x); return fmaf(k, 1.7484555e-7f, r); }
__device__ __forceinline__ float my_sin(float x) { return __sinf(red2pi(x)); }
__device__ __forceinline__ float my_cos(float x) { return __cosf(red2pi(x)); }
__device__ __forceinline__ int rowmap(int reg, int hh) { return (reg & 3) + 8 * (reg >> 2) + 4 * hh; }
__device__ __forceinline__ f32x16 mfma32(bf16x8 a, bf16x8 b, f32x16 c) { return __builtin_amdgcn_mfma_f32_32x32x16_bf16(a, b, c, 0, 0, 0); }
__device__ __forceinline__ bf16x8 pack8(float a0, float a1, float a2, float a3, float a4, float a5, float a6, float a7) {
    u32x4 w; w.x = cvt_pk_bf16(a0, a1); w.y = cvt_pk_bf16(a2, a3); w.z = cvt_pk_bf16(a4, a5); w.w = cvt_pk_bf16(a6, a7);
    return __builtin_bit_cast(bf16x8, w);
}

namespace pg8 {
constexpr int BM = 256, BK = 64, HALF = 128, HTB = HALF * BK * 2, STAGE_BYTES = 8 * HTB, NXCD = 8, WGM = 4;
__device__ __forceinline__ int lds_byte(int r, int c) { const int st = (r >> 4) * 2 + (c >> 5), rr = r & 15, cc = c & 31, ob = rr * 64 + cc * 2; return st * 1024 + (ob ^ (((ob >> 9) & 1) << 5)); }
__device__ __forceinline__ void stage_rc(int b, int& R, int& C) { const int st = b / 1024, sb = b % 1024, swz = sb ^ (((sb >> 9) & 1) << 5); R = (st >> 1) * 16 + swz / 64; C = (st & 1) * 32 + (swz % 64) / 2; }
__device__ __forceinline__ int perm32(int rho) { const int n = rho >> 4, i = rho & 15; return 8 * (i >> 2) + 4 * n + (i & 3); }

struct Unit { const char* A; const char* B; int pm, pn, aux, pad; };
struct Gemm { int K; size_t hstepA, hstepB; };

struct Sched {
    int nM, nN, nwg, G, c, kind;
    const char* A; const char* B; const char* A2; const char* B2; size_t tsA, tsB;
    __device__ __forceinline__ void map(int wgid, int& pm, int& pn) const {
        { const int q = nwg / NXCD, r = nwg % NXCD, xcd = wgid % NXCD, off = wgid / NXCD; wgid = (xcd < r ? xcd * (q + 1) : r * (q + 1) + (xcd - r) * q) + off; }
        const int nig = WGM * nN, gid = wgid / nig, fm = gid * WGM, gsz = (nM - fm) < WGM ? (nM - fm) : WGM;
        pm = fm + ((wgid % nig) % gsz); pn = (wgid % nig) / gsz;
    }
    __device__ __forceinline__ bool next(int i, Unit& u) const {
        if (kind == 2) {
            const long L = (long)(i >> 1) * G + c; if (L >= nwg) return false;
            int pm, pn; map((int)L, pm, pn); u.pm = pm; u.pn = pn; u.aux = i & 1; u.pad = 0;
            u.A = ((i & 1) ? A2 : A) + (size_t)pm * tsA; u.B = ((i & 1) ? B2 : B) + (size_t)pn * tsB; return true;
        }
        const long L = (long)i * G + c; if (L >= nwg) return false;
        int pm, pn; map((int)L, pm, pn); u.pm = pm; u.pn = pn; u.aux = 0; u.pad = 0;
        u.A = A + (size_t)pm * tsA;
        if (kind == 1) { const int seg = pn >> 2; const int rows = (seg < 5 ? seg * 1024 : 8192 + (seg - 5) * 1024) + (pn & 3) * 256; u.B = B + (size_t)rows * (D * 2); }
        else u.B = B + (size_t)pn * tsB;
        return true;
    }
};

template <class Epi, bool ALIGN_EPI = true, bool SP2 = true>
__device__ __forceinline__ void gemm_phase(LAS unsigned char* lds, const Gemm g, const Sched& S, const Epi& E) {
    const int tid = threadIdx.x, wid = __builtin_amdgcn_readfirstlane(tid >> 6), lane = tid & 63, wr = wid >> 2, wc = wid & 3, fr = lane & 15, fq = lane >> 4;
    const int K = g.K, nt = K / BK;
    unsigned voffA[2], voffB[2];
#pragma unroll
    for (int i = 0; i < 2; ++i) { int R, C; stage_rc(tid * 16 + i * 8192, R, C); const int Rb = (R & ~31) + perm32(R & 31);
        voffA[i] = (unsigned)(R * K + C) * 2u; voffB[i] = (unsigned)(Rb * K + C) * 2u; }
    const size_t kstep = (size_t)(BK * 2);
    const size_t hsA = g.hstepA, hsB = g.hstepB;
    const unsigned ldsw = (unsigned)wid * 1024u;
    const int aoff = lds_byte(wr * 64 + fr, fq * 8), boff = lds_byte(wc * 32 + fr, fq * 8);
#define PG8_SA(b, h) (((b) * 2 + (h)) * HTB)
#define PG8_SB(b, h) ((4 + (b) * 2 + (h)) * HTB)
#define PG8_STAGE(bufoff, gbase, voff) do { _Pragma("unroll") for (int _i = 0; _i < 2; ++_i) \
        __builtin_amdgcn_global_load_lds((const unsigned*)((const char*)(gbase) + (voff)[_i]), (LAS unsigned*)(lds + (bufoff) + ldsw + _i * 8192), 16, 0, 0); } while (0)
#define PG8_LDA(dst, b, h) do { _Pragma("unroll") for (int m = 0; m < 4; ++m) _Pragma("unroll") for (int k = 0; k < 2; ++k) dst[m][k] = *(const LAS bf16x8*)(lds + PG8_SA(b, h) + aoff + m * 2048 + k * 1024); } while (0)
#define PG8_LDB(dst, b, h) do { _Pragma("unroll") for (int n = 0; n < 2; ++n) _Pragma("unroll") for (int k = 0; k < 2; ++k) dst[n][k] = *(const LAS bf16x8*)(lds + PG8_SB(b, h) + boff + n * 2048 + k * 1024); } while (0)
#define PG8_MMA(ai, bj, At, Bt) do { __builtin_amdgcn_s_setprio(1); _Pragma("unroll") for (int m = 0; m < 4; ++m) _Pragma("unroll") for (int n = 0; n < 2; ++n) _Pragma("unroll") for (int k = 0; k < 2; ++k) \
        acc[ai][bj][m][n] = __builtin_amdgcn_mfma_f32_16x16x32_bf16(Bt[n][k], At[m][k], acc[ai][bj][m][n], 0, 0, 0); __builtin_amdgcn_s_setprio(0); } while (0)
#define PG8_WAIT_V(n) asm volatile("s_waitcnt vmcnt(" #n ")" ::: "memory")
#define PG8_WAIT_L(n) asm volatile("s_waitcnt lgkmcnt(" #n ")" ::: "memory")
#define PG8_BAR __builtin_amdgcn_s_barrier()
#define PG8_SCHED __builtin_amdgcn_sched_barrier(0)
    Unit cur, nxt; int ui = 0;
    if (!S.next(0, cur)) return;
    f32x4 acc[2][2][4][2];
#pragma unroll
    for (int a = 0; a < 2; ++a)
#pragma unroll
        for (int b = 0; b < 2; ++b)
#pragma unroll
            for (int m = 0; m < 4; ++m)
#pragma unroll
                for (int n = 0; n < 2; ++n) acc[a][b][m][n] = (f32x4){0.f, 0.f, 0.f, 0.f};
    bf16x8 At[4][2], B0[2][2], B1[2][2];
    const char* cA = cur.A; const char* cB = cur.B;
    if constexpr (SP2) {
        PG8_STAGE(PG8_SB(0, 0), cB, voffB); PG8_STAGE(PG8_SB(0, 1), cB + hsB, voffB); PG8_STAGE(PG8_SA(0, 0), cA, voffA); PG8_STAGE(PG8_SA(0, 1), cA + hsA, voffA);
        if (wr == 1) PG8_BAR;
        PG8_WAIT_V(2); PG8_BAR;
        PG8_STAGE(PG8_SB(1, 0), cB + kstep, voffB); PG8_STAGE(PG8_SA(1, 0), cA + kstep, voffA); PG8_STAGE(PG8_SB(1, 1), cB + hsB + kstep, voffB);
        PG8_WAIT_V(6); PG8_BAR;
    } else {
        PG8_STAGE(PG8_SB(0, 0), cB, voffB); PG8_STAGE(PG8_SA(0, 0), cA, voffA); PG8_STAGE(PG8_SB(0, 1), cB + hsB, voffB); PG8_STAGE(PG8_SA(0, 1), cA + hsA, voffA);
        if (wr == 1) PG8_BAR;
        PG8_WAIT_V(4); PG8_BAR;
        PG8_STAGE(PG8_SB(1, 0), cB + kstep, voffB); PG8_STAGE(PG8_SA(1, 0), cA + kstep, voffA); PG8_STAGE(PG8_SB(1, 1), cB + hsB + kstep, voffB);
        PG8_WAIT_V(6); PG8_BAR;
    }
    for (;;) {
        const bool has_next = S.next(ui + 1, nxt);
        const char* nA = has_next ? nxt.A : cA; const char* nB = has_next ? nxt.B : cB;
        for (int t = 0; t < nt; t += 2) {
            const bool last = (t == nt - 2);
            const char* a1 = cA + (size_t)(t + 1) * kstep;
            const char* a2 = last ? nA : cA + (size_t)(t + 2) * kstep; const char* b2 = last ? nB : cB + (size_t)(t + 2) * kstep;
            const char* a3 = a2 + kstep; const char* b3 = b2 + kstep;
            if constexpr (SP2) {
            PG8_LDB(B0, 0, 0); PG8_LDB(B1, 0, 1); PG8_SCHED; PG8_LDA(At, 0, 0); PG8_STAGE(PG8_SA(1, 1), a1 + hsA, voffA);
            PG8_WAIT_V(8); PG8_WAIT_L(0); PG8_BAR; PG8_MMA(0, 0, At, B0); PG8_MMA(0, 1, At, B1); PG8_BAR; PG8_SCHED;
            PG8_LDA(At, 0, 1); PG8_STAGE(PG8_SB(0, 0), b2, voffB); PG8_STAGE(PG8_SB(0, 1), b2 + hsB, voffB); PG8_STAGE(PG8_SA(0, 0), a2, voffA);
            PG8_WAIT_V(8); PG8_WAIT_L(0); PG8_BAR; PG8_MMA(1, 0, At, B0); PG8_MMA(1, 1, At, B1); PG8_BAR; PG8_SCHED;
            PG8_LDB(B0, 1, 0); PG8_LDB(B1, 1, 1); PG8_SCHED; PG8_LDA(At, 1, 0); PG8_STAGE(PG8_SA(0, 1), a2 + hsA, voffA);
            PG8_WAIT_V(8); PG8_WAIT_L(0); PG8_BAR; PG8_MMA(0, 0, At, B0); PG8_MMA(0, 1, At, B1); PG8_BAR; PG8_SCHED;
            PG8_LDA(At, 1, 1); PG8_STAGE(PG8_SB(1, 0), b3, voffB); PG8_STAGE(PG8_SB(1, 1), b3 + hsB, voffB); PG8_STAGE(PG8_SA(1, 0), a3, voffA);
            PG8_WAIT_V(8); PG8_WAIT_L(0); PG8_BAR; PG8_MMA(1, 0, At, B0); PG8_MMA(1, 1, At, B1); PG8_BAR; PG8_SCHED;
            } else {
            PG8_LDB(B0, 0, 0); PG8_SCHED; PG8_LDA(At, 0, 0); PG8_STAGE(PG8_SA(1, 1), a1 + hsA, voffA);
            PG8_WAIT_L(8); PG8_BAR; PG8_WAIT_L(0); PG8_MMA(0, 0, At, B0); PG8_BAR; PG8_SCHED;
            PG8_LDB(B1, 0, 1); PG8_STAGE(PG8_SB(0, 0), b2, voffB);
            PG8_BAR; PG8_WAIT_L(0); PG8_MMA(0, 1, At, B1); PG8_BAR;
            PG8_LDA(At, 0, 1); PG8_STAGE(PG8_SA(0, 0), a2, voffA);
            PG8_BAR; PG8_WAIT_L(0); PG8_MMA(1, 0, At, B0); PG8_BAR; PG8_SCHED;
            PG8_STAGE(PG8_SB(0, 1), b2 + hsB, voffB);
            PG8_WAIT_V(6); PG8_BAR; PG8_MMA(1, 1, At, B1); PG8_BAR;
            PG8_LDB(B0, 1, 0); PG8_SCHED; PG8_LDA(At, 1, 0); PG8_STAGE(PG8_SA(0, 1), a2 + hsA, voffA);
            PG8_WAIT_L(8); PG8_BAR; PG8_WAIT_L(0); PG8_MMA(0, 0, At, B0); PG8_BAR; PG8_SCHED;
            PG8_LDB(B1, 1, 1); PG8_STAGE(PG8_SB(1, 0), b3, voffB);
            PG8_BAR; PG8_WAIT_L(0); PG8_MMA(0, 1, At, B1); PG8_BAR;
            PG8_LDA(At, 1, 1); PG8_STAGE(PG8_SA(1, 0), a3, voffA);
            PG8_BAR; PG8_WAIT_L(0); PG8_MMA(1, 0, At, B0); PG8_BAR; PG8_SCHED;
            PG8_STAGE(PG8_SB(1, 1), b3 + hsB, voffB);
            PG8_WAIT_V(6); PG8_BAR; PG8_MMA(1, 1, At, B1); PG8_BAR;
            }
        }
        if constexpr (ALIGN_EPI) { if (wr == 0) PG8_BAR; }
        E(acc, cur, wr, wc, fr, fq);
        if (!has_next) break;
        if (!E.keep(cur)) {
#pragma unroll
            for (int a = 0; a < 2; ++a)
#pragma unroll
                for (int b = 0; b < 2; ++b)
#pragma unroll
                    for (int m = 0; m < 4; ++m)
#pragma unroll
                        for (int n = 0; n < 2; ++n) acc[a][b][m][n] = (f32x4){0.f, 0.f, 0.f, 0.f};
        }
        cur = nxt; cA = nA; cB = nB; ++ui;
        if constexpr (ALIGN_EPI) { if (wr == 1) PG8_BAR; }
    }
    PG8_WAIT_V(0);
    if constexpr (!ALIGN_EPI) { if (wr == 0) PG8_BAR; }
    PG8_BAR;
#undef PG8_SA
#undef PG8_SB
#undef PG8_STAGE
#undef PG8_LDA
#undef PG8_LDB
#undef PG8_MMA
#undef PG8_WAIT_V
#undef PG8_WAIT_L
#undef PG8_BAR
#undef PG8_SCHED
}
}

typedef f32x4 AccT[2][2][4][2];

struct EpiIn {
    u16* out[7]; const float* LB;
    __device__ __forceinline__ bool keep(const pg8::Unit&) const { return false; }
    template <int ACT> __device__ __forceinline__ void run(AccT& acc, const pg8::Unit& u, int wr, int wc, int fr, int fq, u16* O, const float* lbp) const {
        const int row0 = u.pm * 256 + wr * 64 + fr, colb = (u.pn & 3) * 256 + wc * 32 + 8 * fq;
#pragma unroll
        for (int bj = 0; bj < 2; ++bj) {
            const int col = colb + bj * 128;
            float lbv[8];
            if (ACT == 2) { const f32x4 l0 = *(const f32x4*)(lbp + col), l1 = *(const f32x4*)(lbp + col + 4);
                lbv[0] = l0[0]; lbv[1] = l0[1]; lbv[2] = l0[2]; lbv[3] = l0[3]; lbv[4] = l1[0]; lbv[5] = l1[1]; lbv[6] = l1[2]; lbv[7] = l1[3]; }
#pragma unroll
            for (int ai = 0; ai < 2; ++ai)
#pragma unroll
                for (int m = 0; m < 4; ++m) {
                    const int row = row0 + ai * 128 + m * 16;
                    float v[8];
#pragma unroll
                    for (int e = 0; e < 4; ++e) { v[e] = acc[ai][bj][m][0][e]; v[4 + e] = acc[ai][bj][m][1][e]; }
                    u32x4 w;
                    if (ACT == 2) {
                        unsigned ww[4];
#pragma unroll
                        for (int e = 0; e < 4; ++e) {
                            const float f0 = lbv[2 * e] + (1.f - lbv[2 * e]) * sigmoid_f(v[2 * e]);
                            const float f1 = lbv[2 * e + 1] + (1.f - lbv[2 * e + 1]) * sigmoid_f(v[2 * e + 1]);
                            h16x2 hp; hp.x = (_Float16)__logf(f0); hp.y = (_Float16)__logf(f1);
                            ww[e] = __builtin_bit_cast(unsigned, hp);
                        }
                        w.x = ww[0]; w.y = ww[1]; w.z = ww[2]; w.w = ww[3];
                    } else {
#pragma unroll
                        for (int e = 0; e < 8; ++e) { if (ACT == 1) v[e] = silu_f(v[e]); if (ACT == 3) v[e] = sigmoid_f(v[e]); }
                        w.x = cvt_pk_bf16(v[0], v[1]); w.y = cvt_pk_bf16(v[2], v[3]); w.z = cvt_pk_bf16(v[4], v[5]); w.w = cvt_pk_bf16(v[6], v[7]);
                    }
                    *(u32x4*)(O + (size_t)row * D + col) = w;
                }
        }
    }
    __device__ __forceinline__ void operator()(AccT& acc, const pg8::Unit& u, int wr, int wc, int fr, int fq) const {
        const int seg = u.pn >> 2; u16* O = seg == 0 ? out[0] : seg == 1 ? out[1] : seg == 2 ? out[2] : seg == 3 ? out[3] : seg == 4 ? out[4] : seg == 5 ? out[5] : out[6];
        if (seg == 0 || seg == 4) run<1>(acc, u, wr, wc, fr, fq, O, LB);
        else if (seg == 1 || seg == 2) run<2>(acc, u, wr, wc, fr, fq, O, LB + (seg - 1) * 1024);
        else if (seg == 3) run<0>(acc, u, wr, wc, fr, fq, O, LB);
        else run<3>(acc, u, wr, wc, fr, fq, O, LB);
    }
};
struct EpiBf {
    u16* O; int ld;
    __device__ __forceinline__ bool keep(const pg8::Unit&) const { return false; }
    __device__ __forceinline__ void operator()(AccT& acc, const pg8::Unit& u, int wr, int wc, int fr, int fq) const {
        const int row0 = u.pm * 256 + wr * 64 + fr, colb = u.pn * 256 + wc * 32 + 8 * fq;
#pragma unroll
        for (int ai = 0; ai < 2; ++ai)
#pragma unroll
            for (int m = 0; m < 4; ++m)
#pragma unroll
                for (int bj = 0; bj < 2; ++bj) {
                    const f32x4 v0 = acc[ai][bj][m][0], v1 = acc[ai][bj][m][1];
                    u32x4 w; w.x = cvt_pk_bf16(v0[0], v0[1]); w.y = cvt_pk_bf16(v0[2], v0[3]); w.z = cvt_pk_bf16(v1[0], v1[1]); w.w = cvt_pk_bf16(v1[2], v1[3]);
                    *(u32x4*)(O + (size_t)(row0 + ai * 128 + m * 16) * ld + colb + bj * 128) = w;
                }
    }
};
struct EpiMerge {
    const u16* GA; const u16* GB; u16* T1;
    __device__ __forceinline__ bool keep(const pg8::Unit& u) const { return u.aux == 0; }
    __device__ __forceinline__ void operator()(AccT& acc, const pg8::Unit& u, int wr, int wc, int fr, int fq) const {
        const int row0 = u.pm * 256 + wr * 64 + fr, colb = u.pn * 256 + wc * 32 + 8 * fq;
#pragma unroll
        for (int ai = 0; ai < 2; ++ai)
#pragma unroll
            for (int m = 0; m < 4; ++m)
#pragma unroll
                for (int bj = 0; bj < 2; ++bj) {
                    const size_t idx = (size_t)(row0 + ai * 128 + m * 16) * D + colb + bj * 128;
                    const u32x4 gb = *(const u32x4*)(GB + idx);
                    float b[8] = {bflo(gb.x), bfhi(gb.x), bflo(gb.y), bfhi(gb.y), bflo(gb.z), bfhi(gb.z), bflo(gb.w), bfhi(gb.w)};
                    if (u.aux == 0) {
                        const u32x4 ga = *(const u32x4*)(GA + idx);
                        float a[8] = {bflo(ga.x), bfhi(ga.x), bflo(ga.y), bfhi(ga.y), bflo(ga.z), bfhi(ga.z), bflo(ga.w), bfhi(ga.w)};
#pragma unroll
                        for (int e = 0; e < 4; ++e) { acc[ai][bj][m][0][e] *= a[e] * __builtin_amdgcn_rcpf(fmaxf(b[e], 1e-30f)); acc[ai][bj][m][1][e] *= a[4 + e] * __builtin_amdgcn_rcpf(fmaxf(b[4 + e], 1e-30f)); }
                    } else {
                        const f32x4 v0 = acc[ai][bj][m][0], v1 = acc[ai][bj][m][1];
                        u32x4 w; w.x = cvt_pk_bf16(v0[0] * b[0], v0[1] * b[1]); w.y = cvt_pk_bf16(v0[2] * b[2], v0[3] * b[3]);
                        w.z = cvt_pk_bf16(v1[0] * b[4], v1[1] * b[5]); w.w = cvt_pk_bf16(v1[2] * b[6], v1[3] * b[7]);
                        *(u32x4*)(T1 + idx) = w;
                    }
                }
    }
};
template <bool RBF>
struct EpiRes {
    const void* R0; const void* R1; const float* gate; u16* O;
    __device__ __forceinline__ bool keep(const pg8::Unit&) const { return false; }
    __device__ __forceinline__ void operator()(AccT& acc, const pg8::Unit& u, int wr, int wc, int fr, int fq) const {
        const int row0 = u.pm * 256 + wr * 64 + fr, colb = u.pn * 256 + wc * 32 + 8 * fq;
        const float* gp = gate + (size_t)cid_of(u.pm * 256) * NMOD;
#pragma unroll
        for (int bj = 0; bj < 2; ++bj) {
            const int col = colb + bj * 128;
            const f32x4 g0 = *(const f32x4*)(gp + col), g1 = *(const f32x4*)(gp + col + 4);
#pragma unroll
            for (int ai = 0; ai < 2; ++ai)
#pragma unroll
                for (int m = 0; m < 4; ++m) {
                    const int row = row0 + ai * 128 + m * 16;
                    float x[8];
                    if (RBF) {
                        const u32x4 xr = *(const u32x4*)((const u16*)R0 + (size_t)row * D + col);
                        x[0] = bflo(xr.x); x[1] = bfhi(xr.x); x[2] = bflo(xr.y); x[3] = bfhi(xr.y); x[4] = bflo(xr.z); x[5] = bfhi(xr.z); x[6] = bflo(xr.w); x[7] = bfhi(xr.w);
                    } else {
                        const float* rp = (row < 8192 ? (const float*)R0 + (size_t)row * D : (const float*)R1 + (size_t)(row - 8192) * D) + col;
                        const f32x4 x0 = *(const f32x4*)rp, x1 = *(const f32x4*)(rp + 4);
                        x[0] = x0[0]; x[1] = x0[1]; x[2] = x0[2]; x[3] = x0[3]; x[4] = x1[0]; x[5] = x1[1]; x[6] = x1[2]; x[7] = x1[3];
                    }
                    float o[8];
#pragma unroll
                    for (int e = 0; e < 4; ++e) { o[e] = ALPHA * x[e] + g0[e] * acc[ai][bj][m][0][e]; o[4 + e] = ALPHA * x[4 + e] + g1[e] * acc[ai][bj][m][1][e]; }
                    u32x4 w; w.x = cvt_pk_bf16(o[0], o[1]); w.y = cvt_pk_bf16(o[2], o[3]); w.z = cvt_pk_bf16(o[4], o[5]); w.w = cvt_pk_bf16(o[6], o[7]);
                    *(u32x4*)(O + (size_t)row * D + col) = w;
                }
        }
    }
};
struct EpiGlu {
    u16* FF;
    __device__ __forceinline__ bool keep(const pg8::Unit&) const { return false; }
    __device__ __forceinline__ void operator()(AccT& acc, const pg8::Unit& u, int wr, int wc, int fr, int fq) const {
        const int row0 = u.pm * 256 + wr * 64 + fr, col = u.pn * 128 + wc * 32 + 8 * fq;
#pragma unroll
        for (int ai = 0; ai < 2; ++ai)
#pragma unroll
            for (int m = 0; m < 4; ++m) {
                float v[8];
#pragma unroll
                for (int e = 0; e < 4; ++e) { v[e] = silu_f(acc[ai][0][m][0][e]) * acc[ai][1][m][0][e]; v[4 + e] = silu_f(acc[ai][0][m][1][e]) * acc[ai][1][m][1][e]; }
                u32x4 w; w.x = cvt_pk_bf16(v[0], v[1]); w.y = cvt_pk_bf16(v[2], v[3]); w.z = cvt_pk_bf16(v[4], v[5]); w.w = cvt_pk_bf16(v[6], v[7]);
                *(u32x4*)(FF + (size_t)(row0 + ai * 128 + m * 16) * DFF + col) = w;
            }
    }
};

__device__ __forceinline__ void convert_tile4(LAS unsigned char* lds, const float* W, u16* WT, int K, int N, int su) {
    LAS float* tl = (LAS float*)lds;
    const int tiles_n = N >> 8, tk = su / tiles_n, tn = su - tk * tiles_n, k0 = tk * 64, n0 = tn * 256, tid = threadIdx.x;
    {
        const int kr = tid >> 6, nc = (tid & 63) * 4;
        f32x4 v[8];
#pragma unroll
        for (int it = 0; it < 8; ++it) v[it] = *(const f32x4*)(W + (size_t)(k0 + kr + 8 * it) * N + n0 + nc);
#pragma unroll
        for (int it = 0; it < 8; ++it) { LAS float* d = tl + (kr + 8 * it) * 257 + nc; d[0] = v[it][0]; d[1] = v[it][1]; d[2] = v[it][2]; d[3] = v[it][3]; }
    }
    __syncthreads();
    {
        const int nr = tid >> 1, kc = (tid & 1) * 32;
#pragma unroll
        for (int q = 0; q < 4; ++q) {
            float v[8];
#pragma unroll
            for (int e = 0; e < 8; ++e) v[e] = tl[(kc + 8 * q + e) * 257 + nr];
            u32x4 w; w.x = cvt_pk_bf16(v[0], v[1]); w.y = cvt_pk_bf16(v[2], v[3]); w.z = cvt_pk_bf16(v[4], v[5]); w.w = cvt_pk_bf16(v[6], v[7]);
            *(u32x4*)(WT + (size_t)(n0 + nr) * K + k0 + kc + 8 * q) = w;
        }
    }
    __syncthreads();
}

__device__ __forceinline__ void phase_prep(LAS unsigned char* lds, const Ctx& C) {
    const int tid = threadIdx.x;
    u16* WIN = (u16*)(C.ws + WS_WIN); u16* WPA = (u16*)(C.ws + WS_WPA); u16* WPB = (u16*)(C.ws + WS_WPB); u16* WOUT = (u16*)(C.ws + WS_WOUT);
    float* MOD = (float*)(C.ws + WS_MOD); float* LB = (float*)(C.ws + WS_LB);
    constexpr int N_CV = 640 + 64 * 3, N_MODU = 192, N_H3 = 272, N_ALL = N_CV + N_MODU + N_H3 + 1;
    for (int u = blockIdx.x; u < N_ALL; u += gridDim.x) {
        if (u < N_CV) {
            if (u < 640) convert_tile4(lds, C.in[7], WIN, 1024, NIN, u);
            else if (u < 704) convert_tile4(lds, C.in[21], WPA, 1024, 1024, u - 640);
            else if (u < 768) convert_tile4(lds, C.in[22], WPB, 1024, 1024, u - 704);
            else convert_tile4(lds, C.in[23], WOUT, 1024, 1024, u - 768);
        } else if (u < N_CV + N_MODU) {
            const int mu = u - N_CV, n0 = mu * 32, col = tid & 31, ks = tid >> 5;
            const float* cctx = C.in[4]; const float* cc = C.in[3]; const float* aw = C.in[5];
            LAS float* sc = (LAS float*)lds;
            LAS float* red = (LAS float*)(lds + 12288);
            for (int i = tid; i < 3072; i += 512) sc[i] = silu_f(i < 1024 ? cctx[i] : cc[i - 1024]);
            __syncthreads();
            float a0 = 0.f, a1 = 0.f, a2 = 0.f;
#pragma unroll
            for (int kb = 0; kb < 64; kb += 16) {
                float w[16];
#pragma unroll
                for (int kk = 0; kk < 16; ++kk) w[kk] = aw[(size_t)(ks * 64 + kb + kk) * NMOD + n0 + col];
#pragma unroll
                for (int kk = 0; kk < 16; ++kk) { const int k = ks * 64 + kb + kk; a0 += sc[k] * w[kk]; a1 += sc[1024 + k] * w[kk]; a2 += sc[2048 + k] * w[kk]; }
            }
            red[(0 * 16 + ks) * 32 + col] = a0; red[(1 * 16 + ks) * 32 + col] = a1; red[(2 * 16 + ks) * 32 + col] = a2;
            __syncthreads();
            if (tid < 96) { const int ci = tid >> 5, c2 = tid & 31; float s2 = C.in[6][n0 + c2];
#pragma unroll
                for (int k = 0; k < 16; ++k) s2 += red[(ci * 16 + k) * 32 + c2];
                MOD[ci * NMOD + n0 + c2] = s2; }
            __syncthreads();
        } else if (u < N_CV + N_MODU + N_H3) {
            const int hu = u - N_CV - N_MODU, pl = tid >> 6, j = tid & 63;
            LAS float* zs = (LAS float*)lds;
            LAS float* h1 = (LAS float*)(lds + 4096);
            LAS float* h2 = (LAS float*)(lds + 8192);
            u16* Hhi[2]; u16* Hlo[2];
#pragma unroll
            for (int pp = 0; pp < 2; ++pp) {
                const int pos = hu * 16 + pl + 8 * pp;
                const int L = pos < 256 ? 256 : 4096, t = pos < 256 ? pos : pos - 256;
                Hhi[pp] = pos < 256 ? (u16*)(C.ws + WS_H3P) + (size_t)t * 64 : (u16*)(C.ws + WS_H3S) + (size_t)t * 64;
                Hlo[pp] = Hhi[pp] + (pos < 256 ? 256 * 64 : 4096 * 64);
                if (j < 33) {
                    float z;
                    if (j == 0) z = (float)t / (float)(L - 1);
                    else {
                        const int bnd = (j - 1) & 15;
                        const float band = 1e-4f + (float)bnd * ((15.0f - 1e-4f) / 15.0f);
                        const float wpos = (float)(6.283185307179586 / (double)L) * (float)t;
                        const float ang = band * wpos;
                        z = (j <= 16) ? my_cos(ang) : -my_sin(ang);
                    }
                    zs[(pl + 8 * pp) * 40 + j] = z;
                }
            }
            __syncthreads();
            const float* fq = C.in[18];
            { float s0 = C.in[13][j], s1 = s0; const float* w1 = C.in[12];
#pragma unroll 11
              for (int i = 0; i < 33; ++i) { const float w = w1[i * 64 + j]; s0 += zs[pl * 40 + i] * w; s1 += zs[(pl + 8) * 40 + i] * w; }
              h1[pl * 64 + j] = my_sin(fq[j] * s0); h1[(pl + 8) * 64 + j] = my_sin(fq[j] * s1); }
            __syncthreads();
            { float s0 = C.in[15][j], s1 = s0; const float* w2 = C.in[14];
#pragma unroll 32
              for (int i = 0; i < 64; ++i) { const float w = w2[i * 64 + j]; s0 += h1[pl * 64 + i] * w; s1 += h1[(pl + 8) * 64 + i] * w; }
              h2[pl * 64 + j] = my_sin(fq[64 + j] * s0); h2[(pl + 8) * 64 + j] = my_sin(fq[64 + j] * s1); }
            __syncthreads();
            { float s0 = C.in[17][j], s1 = s0; const float* w3 = C.in[16];
#pragma unroll 32
              for (int i = 0; i < 64; ++i) { const float w = w3[i * 64 + j]; s0 += h2[pl * 64 + i] * w; s1 += h2[(pl + 8) * 64 + i] * w; }
              const float hv0 = my_sin(fq[128 + j] * s0), hv1 = my_sin(fq[128 + j] * s1);
              const u16 hb0 = f2bf(hv0), hb1 = f2bf(hv1);
              Hhi[0][j] = hb0; Hlo[0][j] = f2bf(hv0 - bf2f(hb0)); Hhi[1][j] = hb1; Hlo[1][j] = f2bf(hv1 - bf2f(hb1)); }
            __syncthreads();
        } else {
            const float* lg = C.in[8];
            for (int i = tid; i < 2048; i += 512) LB[i] = 1.f / (1.f + expf(lg[2048 + i] - lg[i]));
        }
    }
}

__device__ __forceinline__ void phase_modulate(const Ctx& C) {
    const int tid = threadIdx.x, c8 = (tid & 127) * 8, r4 = tid >> 7;
    const float* MOD = (const float*)(C.ws + WS_MOD); u16* HB = (u16*)(C.ws + WS_HB);
    for (int ch = blockIdx.x; ch < T / 64; ch += gridDim.x) {
        const int tok0 = ch * 64; const float* mp = MOD + (size_t)cid_of(tok0) * NMOD;
        float sh[8], sc[8];
#pragma unroll
        for (int e = 0; e < 8; ++e) { sh[e] = mp[c8 + e]; sc[e] = 1.f + mp[1024 + c8 + e]; }
#pragma unroll
        for (int hb = 0; hb < 2; ++hb) {
            f32x4 a[8], b[8];
#pragma unroll
            for (int it = 0; it < 8; ++it) { const float* xp = C.xrow(tok0 + r4 + 4 * (8 * hb + it)) + c8; a[it] = *(const f32x4*)xp; b[it] = *(const f32x4*)(xp + 4); }
#pragma unroll
            for (int it = 0; it < 8; ++it) {
                const int tok = tok0 + r4 + 4 * (8 * hb + it);
                u32x4 w; w.x = cvt_pk_bf16(a[it][0] * sc[0] + sh[0], a[it][1] * sc[1] + sh[1]); w.y = cvt_pk_bf16(a[it][2] * sc[2] + sh[2], a[it][3] * sc[3] + sh[3]);
                w.z = cvt_pk_bf16(b[it][0] * sc[4] + sh[4], b[it][1] * sc[5] + sh[5]); w.w = cvt_pk_bf16(b[it][2] * sc[6] + sh[6], b[it][3] * sc[7] + sh[7]);
                *(u32x4*)(HB + (size_t)tok * D + c8) = w;
            }
        }
    }
}

__device__ __forceinline__ float wave_sum(float v) {
#pragma unroll
    for (int o = 32; o >= 1; o >>= 1) v += __shfl_xor(v, o, 64);
    return v;
}
template <bool WITH_H>
__device__ __forceinline__ void phase_ln(const Ctx& C, const u16* U, float* Y, u16* Y16, const float* gam, const float* bet, u16* H, int scale_idx, int shift_idx) {
    const int lane = threadIdx.x & 63, wv = threadIdx.x >> 6;
    const float* MOD = (const float*)(C.ws + WS_MOD);
    for (int row0 = (blockIdx.x * 8 + wv) * 4; row0 < T; row0 += gridDim.x * 32) {
        u32x4 raw[4][2];
#pragma unroll
        for (int rr = 0; rr < 4; ++rr)
#pragma unroll
            for (int i = 0; i < 2; ++i) raw[rr][i] = *(const u32x4*)(U + (size_t)(row0 + rr) * D + 8 * lane + 512 * i);
        const float* mp = MOD + (size_t)cid_of(row0) * NMOD;
#pragma unroll
        for (int rr = 0; rr < 4; ++rr) {
            const int row = row0 + rr;
            float v[2][8];
#pragma unroll
            for (int i = 0; i < 2; ++i) { const u32x4 r = raw[rr][i];
                v[i][0] = bflo(r.x); v[i][1] = bfhi(r.x); v[i][2] = bflo(r.y); v[i][3] = bfhi(r.y); v[i][4] = bflo(r.z); v[i][5] = bfhi(r.z); v[i][6] = bflo(r.w); v[i][7] = bfhi(r.w); }
            float s = 0.f;
#pragma unroll
            for (int i = 0; i < 2; ++i)
#pragma unroll
                for (int e = 0; e < 8; ++e) s += v[i][e];
            const float mu = wave_sum(s) * (1.f / 1024.f);
            float q = 0.f;
#pragma unroll
            for (int i = 0; i < 2; ++i)
#pragma unroll
                for (int e = 0; e < 8; ++e) { const float d = v[i][e] - mu; q += d * d; }
            const float rstd = rsqrtf(wave_sum(q) * (1.f / 1024.f) + 1e-5f);
#pragma unroll
            for (int i = 0; i < 2; ++i) {
                const int col = 8 * lane + 512 * i;
                const f32x4 g0 = *(const f32x4*)(gam + col), g1 = *(const f32x4*)(gam + col + 4), b0 = *(const f32x4*)(bet + col), b1 = *(const f32x4*)(bet + col + 4);
                float y[8];
#pragma unroll
                for (int e = 0; e < 4; ++e) { y[e] = (v[i][e] - mu) * rstd * g0[e] + b0[e]; y[4 + e] = (v[i][4 + e] - mu) * rstd * g1[e] + b1[e]; }
                if (WITH_H) {
                    u32x4 w; w.x = cvt_pk_bf16(y[0], y[1]); w.y = cvt_pk_bf16(y[2], y[3]); w.z = cvt_pk_bf16(y[4], y[5]); w.w = cvt_pk_bf16(y[6], y[7]);
                    *(u32x4*)(Y16 + (size_t)row * D + col) = w;
                    const f32x4 sc0 = *(const f32x4*)(mp + scale_idx * 1024 + col), sc1 = *(const f32x4*)(mp + scale_idx * 1024 + col + 4);
                    const f32x4 sh0 = *(const f32x4*)(mp + shift_idx * 1024 + col), sh1 = *(const f32x4*)(mp + shift_idx * 1024 + col + 4);
                    float hv[8];
#pragma unroll
                    for (int e = 0; e < 4; ++e) { hv[e] = y[e] * (1.f + sc0[e]) + sh0[e]; hv[4 + e] = y[4 + e] * (1.f + sc1[e]) + sh1[e]; }
                    w.x = cvt_pk_bf16(hv[0], hv[1]); w.y = cvt_pk_bf16(hv[2], hv[3]); w.z = cvt_pk_bf16(hv[4], hv[5]); w.w = cvt_pk_bf16(hv[6], hv[7]);
                    *(u32x4*)(H + (size_t)row * D + col) = w;
                } else {
                    float* yp = Y + (size_t)row * D + col;
                    *(f32x4*)yp = (f32x4){y[0], y[1], y[2], y[3]}; *(f32x4*)(yp + 4) = (f32x4){y[4], y[5], y[6], y[7]};
                }
            }
        }
    }
}

__device__ __forceinline__ void short_conv8(const u16* row, int p0, int RL, float w0, float w1, float w2, float bias, float* out) {
    const u32x4 raw = *(const u32x4*)(row + p0);
    float u[10];
    u[1] = bflo(raw.x); u[2] = bfhi(raw.x); u[3] = bflo(raw.y); u[4] = bfhi(raw.y); u[5] = bflo(raw.z); u[6] = bfhi(raw.z); u[7] = bflo(raw.w); u[8] = bfhi(raw.w);
    u[0] = (p0 & (RL - 1)) != 0 ? bf2f(row[p0 - 1]) : 0.f;
    u[9] = ((p0 + 8) & (RL - 1)) != 0 ? bf2f(row[p0 + 8]) : 0.f;
#pragma unroll
    for (int e = 0; e < 8; ++e) out[e] = w0 * u[e] + w1 * u[e + 1] + w2 * u[e + 2] + bias;
}
__device__ __forceinline__ int zswz(int p8) { return 80 * (p8 >> 2) + 16 * (p8 & 3); }

struct ToepRaw { unsigned w0, w1, w2, w3, w4; };
__device__ __forceinline__ ToepRaw toep_load(const LAS unsigned* FRw, int mb) {
    const int dw = mb >> 1; ToepRaw r; r.w0 = FRw[dw]; r.w1 = FRw[dw + 1]; r.w2 = FRw[dw + 2]; r.w3 = FRw[dw + 3]; r.w4 = FRw[dw + 4]; return r;
}
__device__ __forceinline__ bf16x8 toep_align(const ToepRaw& r, unsigned sh) {
    u32x4 o; o.x = __builtin_amdgcn_alignbyte(r.w1, r.w0, sh); o.y = __builtin_amdgcn_alignbyte(r.w2, r.w1, sh); o.z = __builtin_amdgcn_alignbyte(r.w3, r.w2, sh); o.w = __builtin_amdgcn_alignbyte(r.w4, r.w3, sh);
    return __builtin_bit_cast(bf16x8, o);
}
__device__ __forceinline__ int zaddr(int b, int piece) { return 64 * b + 16 * (piece ^ ((b >> 2) & 3)); }
template <int M>
__device__ __forceinline__ void toep_run(f32x16 (&acc)[4], const LAS unsigned* FRw, int mb0, const LAS unsigned char* Zc, int b00, int sstep, int tstep, int g, int k0, int k1) {
    const unsigned sh = (unsigned)(mb0 & 1) * 2u;
    ToepRaw r0 = toep_load(FRw, mb0 - 32 * k0), r1 = toep_load(FRw, mb0 - 32 * k0 + 16);
    bf16x8 bc[4][2];
#pragma unroll
    for (int j = 0; j < 4; ++j) if ((M >> j) & 1) { const int b = b00 + (j & 1) * sstep + (j >> 1) * tstep - k0; bc[j][0] = *(const LAS bf16x8*)(Zc + zaddr(b, g)); bc[j][1] = *(const LAS bf16x8*)(Zc + zaddr(b, 2 + g)); }
#pragma unroll 1
    for (int k = k0; k <= k1; ++k) {
        const bf16x8 a0 = toep_align(r0, sh), a1 = toep_align(r1, sh);
        const int kn = k < k1 ? k + 1 : k;
        r0 = toep_load(FRw, mb0 - 32 * kn); r1 = toep_load(FRw, mb0 - 32 * kn + 16);
        bf16x8 bn[4][2];
#pragma unroll
        for (int j = 0; j < 4; ++j) if ((M >> j) & 1) { const int b = b00 + (j & 1) * sstep + (j >> 1) * tstep - kn; bn[j][0] = *(const LAS bf16x8*)(Zc + zaddr(b, g)); bn[j][1] = *(const LAS bf16x8*)(Zc + zaddr(b, 2 + g)); }
#pragma unroll
        for (int j = 0; j < 4; ++j) if ((M >> j) & 1) acc[j] = mfma32(a0, bc[j][0], acc[j]);
#pragma unroll
        for (int j = 0; j < 4; ++j) if ((M >> j) & 1) acc[j] = mfma32(a1, bc[j][1], acc[j]);
#pragma unroll
        for (int j = 0; j < 4; ++j) if ((M >> j) & 1) { bc[j][0] = bn[j][0]; bc[j][1] = bn[j][1]; }
    }
}

__device__ __forceinline__ void conv_unit(LAS unsigned char* lds, const Ctx& C, int smp, int cgi) {
    const int tid = threadIdx.x, lane = tid & 63, wv = tid >> 6;
    const int L = smp ? 4096 : 256, nb = L >> 5, lnb = smp ? 7 : 3, RL = smp ? 64 : 256, utok0 = smp ? 8192 : 0, d0 = 4 * cgi;
    const int P = smp ? 31 : 7, nblk = smp ? 349 : 487, ZCH = nblk * 64, FRS = 4 * L;
    const u16* H3hi = smp ? (const u16*)(C.ws + WS_H3S) : (const u16*)(C.ws + WS_H3P);
    const u16* H3lo = H3hi + (size_t)L * 64;
    const u16* HYT = (const u16*)(C.ws + WS_R60);
    u16* OB = (u16*)C.out;
    LAS unsigned char* FRb = lds;
    LAS unsigned char* Zb = lds + 4 * FRS;
#define ZPOS(n) (P + ((n) >> lnb) * (nb + P) + ((n) & (nb - 1)))
    {
        const int n = lane & 31, hh = lane >> 5, o = n & 7, c = o & 3;
        const int gcol = (o >> 2) * 1024 + d0 + c;
        bf16x8 Bhi[4], Blo[4];
#pragma unroll
        for (int kk = 0; kk < 4; ++kk) {
            float wv8[8], wl8[8];
#pragma unroll
            for (int e = 0; e < 8; ++e) {
                const float w = (n < 8) ? C.in[19][(size_t)(16 * kk + 8 * hh + e) * 2048 + gcol] : 0.f;
                const float whi = bf2f(f2bf(w)); wv8[e] = whi; wl8[e] = w - whi;
            }
            Bhi[kk] = pack8(wv8[0], wv8[1], wv8[2], wv8[3], wv8[4], wv8[5], wv8[6], wv8[7]);
            Blo[kk] = pack8(wl8[0], wl8[1], wl8[2], wl8[3], wl8[4], wl8[5], wl8[6], wl8[7]);
        }
        const float mind = -3.0701134573253943f, maxd = -15.350567286626972f;
        const float escale = -1.4426950408889634f / (float)(L - 1);
        float delta4[4], skip4[4];
#pragma unroll
        for (int cc = 0; cc < 4; ++cc) { delta4[cc] = fabsf(mind + (maxd - mind) * ((float)(d0 + cc) / 1023.f)); skip4[cc] = C.in[20][d0 + cc]; }
        if (tid < 4) ((LAS u16*)(FRb + tid * FRS))[0] = 0;
        const int nrb = L >> 5;
        const int wvu = __builtin_amdgcn_readfirstlane(wv);
        LAS unsigned char* stg = Zb + wvu * 8192;
        const int goff0 = (lane >> 3) * 128 + 16 * ((lane & 7) ^ ((lane >> 3) & 7));
#define FILT_DMA(rbx) do { const unsigned char* gh_ = (const unsigned char*)H3hi + (size_t)(rbx) * 4096; const unsigned char* gl_ = (const unsigned char*)H3lo + (size_t)(rbx) * 4096; \
        _Pragma("unroll") for (int q = 0; q < 4; ++q) { \
            __builtin_amdgcn_global_load_lds((const unsigned*)(gh_ + goff0 + 1024 * q), (LAS unsigned*)(stg + 1024 * q), 16, 0, 0); \
            __builtin_amdgcn_global_load_lds((const unsigned*)(gl_ + goff0 + 1024 * q), (LAS unsigned*)(stg + 4096 + 1024 * q), 16, 0, 0); } } while (0)
        if (wvu < nrb) FILT_DMA(wvu);
        for (int rb = wvu; rb < nrb; rb += 8) {
            asm volatile("s_waitcnt vmcnt(0)" ::: "memory");
            bf16x8 xh[4], xl[4];
#pragma unroll
            for (int kk = 0; kk < 4; ++kk) { const int off = n * 128 + 16 * ((2 * kk + hh) ^ (n & 7));
                xh[kk] = *(const LAS bf16x8*)(stg + off); xl[kk] = *(const LAS bf16x8*)(stg + 4096 + off); }
            asm volatile("s_waitcnt lgkmcnt(0)" ::: "memory");
            if (rb + 8 < nrb) FILT_DMA(rb + 8);
            f32x16 acc;
#pragma unroll
            for (int e = 0; e < 16; ++e) acc[e] = 0.f;
#pragma unroll
            for (int kk = 0; kk < 4; ++kk) { acc = mfma32(Bhi[kk], xh[kk], acc); acc = mfma32(Bhi[kk], xl[kk], acc); acc = mfma32(Blo[kk], xh[kk], acc); }
            {
                const int tt = 32 * rb + n;
                const float tsc = (float)tt * escale;
#pragma unroll
                for (int cc = 0; cc < 4; ++cc) {
                    const float win = __builtin_amdgcn_exp2f(tsc * delta4[cc]) + 0.05f;
                    float val = acc[cc] * win;
                    LAS u16* frc = (LAS u16*)(FRb + cc * FRS);
                    if (hh == 0) { if (tt == 0) val += skip4[cc]; frc[L - tt] = f2bf(val); }
                    else if (tt > 0) frc[L + tt] = f2bf(val);
                }
            }
        }
    }
#undef FILT_DMA
    __syncthreads();
    for (int o16 = tid; o16 < ZCH / 4; o16 += 512) *(LAS u32x4*)(Zb + 16 * o16) = (u32x4){0u, 0u, 0u, 0u};
    __syncthreads();
    {
        const float* cw = C.in[10]; const float* cb = C.in[11];
#pragma unroll
        for (int it = 0; it < 8; ++it) {
            const int c = it >> 1, q = tid + 512 * (it & 1), p0 = 8 * q;
            const int c1 = 1024 + d0 + c, c2 = 2048 + d0 + c;
            float s1[8], s2[8];
            short_conv8(HYT + (size_t)c1 * T + utok0, p0, RL, cw[c1], cw[3072 + c1], cw[6144 + c1], cb[c1], s1);
            short_conv8(HYT + (size_t)c2 * T + utok0, p0, RL, cw[c2], cw[3072 + c2], cw[6144 + c2], cb[c2], s2);
            u32x4 w; w.x = cvt_pk_bf16(s1[0] * s2[0], s1[1] * s2[1]); w.y = cvt_pk_bf16(s1[2] * s2[2], s1[3] * s2[3]);
            w.z = cvt_pk_bf16(s1[4] * s2[4], s1[5] * s2[5]); w.w = cvt_pk_bf16(s1[6] * s2[6], s1[7] * s2[7]);
            *(LAS u32x4*)(Zb + c * ZCH + zaddr(ZPOS(q >> 2), q & 3)) = w;
        }
    }
    __syncthreads();
    const int ch = wv >> 1, sub = wv & 1, i = lane & 31, g = lane >> 5;
    const LAS unsigned* FRw = (const LAS unsigned*)(FRb + ch * FRS);
    const LAS unsigned char* Zc = Zb + ch * ZCH;
    f32x16 acc[4];
#pragma unroll
    for (int j = 0; j < 4; ++j)
#pragma unroll
        for (int e = 0; e < 16; ++e) acc[j][e] = 0.f;
    const int mb0 = L - i + 8 * g;
    const int t0s = sub, t1s = sub ? 2 : 3;
    const int b00 = smp ? (31 + 32 * t0s + i) : ZPOS(32 * 4 * sub + i);
    const int sstep = smp ? 159 : 60, tstep = smp ? 32 * (t1s - t0s) : 120;
    if (smp) {
        if (sub == 0) {
            toep_run<3>(acc, FRw, mb0, Zc, b00, sstep, tstep, g, -127, -32);
            toep_run<15>(acc, FRw, mb0, Zc, b00, sstep, tstep, g, -31, 31);
            toep_run<12>(acc, FRw, mb0, Zc, b00, sstep, tstep, g, 32, 127);
        } else {
            toep_run<3>(acc, FRw, mb0, Zc, b00, sstep, tstep, g, -95, -64);
            toep_run<15>(acc, FRw, mb0, Zc, b00, sstep, tstep, g, -63, 63);
            toep_run<12>(acc, FRw, mb0, Zc, b00, sstep, tstep, g, 64, 95);
        }
    } else {
        toep_run<15>(acc, FRw, mb0, Zc, b00, sstep, tstep, g, -7, 7);
    }
    __syncthreads();
    {
        const float* cw = C.in[10]; const float* cb = C.in[11];
#pragma unroll
        for (int it = 0; it < 8; ++it) {
            const int c = it >> 1, q = tid + 512 * (it & 1), p0 = 8 * q, c0 = d0 + c;
            float s0[8];
            short_conv8(HYT + (size_t)c0 * T + utok0, p0, RL, cw[c0], cw[3072 + c0], cw[6144 + c0], cb[c0], s0);
            u32x4 w; w.x = cvt_pk_bf16(s0[0], s0[1]); w.y = cvt_pk_bf16(s0[2], s0[3]); w.z = cvt_pk_bf16(s0[4], s0[5]); w.w = cvt_pk_bf16(s0[6], s0[7]);
            *(LAS u32x4*)(Zb + c * ZCH + zaddr(ZPOS(q >> 2), q & 3)) = w;
        }
    }
    __syncthreads();
    {
        u16* orow = OB + (size_t)(d0 + ch) * T + utok0;
#pragma unroll
        for (int j = 0; j < 4; ++j) {
            const int n = smp ? 128 * (j & 1) + 32 * ((j >> 1) ? t1s : t0s) + i : 32 * (4 * sub + j) + i;
#pragma unroll
            for (int q = 0; q < 4; ++q) {
                const int p = n * 32 + 8 * q + 4 * g;
                const u32x2 xr = *(const LAS u32x2*)(Zc + zaddr(b00 + (j & 1) * sstep + (j >> 1) * tstep, q) + 8 * g);
                u32x2 w; w.x = cvt_pk_bf16(acc[j][4 * q] * bflo(xr.x), acc[j][4 * q + 1] * bfhi(xr.x)); w.y = cvt_pk_bf16(acc[j][4 * q + 2] * bflo(xr.y), acc[j][4 * q + 3] * bfhi(xr.y));
                *(u32x2*)(orow + p) = w;
            }
        }
    }
    __syncthreads();
#undef ZPOS
}

__device__ __forceinline__ void phase_transpose_ob(LAS unsigned char* lds, const Ctx& C) {
    const u16* src = (const u16*)C.out; u16* dst = (u16*)(C.ws + WS_LFF);
    LAS u16* tl = (LAS u16*)lds;
    const int tid = threadIdx.x, r8 = tid >> 3, pc = tid & 7;
    for (int t4 = blockIdx.x; t4 < 16 * 64; t4 += gridDim.x) {
        const int c0 = (t4 >> 6) * 64, k00 = (t4 & 63) * 256;
        u32x4 v[4];
#pragma unroll
        for (int q = 0; q < 4; ++q) v[q] = *(const u32x4*)(src + (size_t)(c0 + r8) * T + k00 + 64 * q + 8 * pc);
#pragma unroll
        for (int q = 0; q < 4; ++q) { LAS unsigned* wp = (LAS unsigned*)(tl + q * 4224 + r8 * 66 + 8 * pc); wp[0] = v[q].x; wp[1] = v[q].y; wp[2] = v[q].z; wp[3] = v[q].w; }
        __syncthreads();
#pragma unroll
        for (int q = 0; q < 4; ++q) {
            unsigned o[4];
#pragma unroll
            for (int e = 0; e < 4; ++e) o[e] = (unsigned)tl[q * 4224 + (8 * pc + 2 * e) * 66 + r8] | ((unsigned)tl[q * 4224 + (8 * pc + 2 * e + 1) * 66 + r8] << 16);
            u32x4 w; w.x = o[0]; w.y = o[1]; w.z = o[2]; w.w = o[3];
            *(u32x4*)(dst + (size_t)(k00 + 64 * q + r8) * D + c0 + 8 * pc) = w;
        }
        __syncthreads();
    }
}

constexpr int SC_QIN = 0, SC_KIN = 8704, SC_KST = 17408, SC_VT = 27648, SC_DEC = 37888, SC_BUF = 38400, SC_HALF = 2 * SC_BUF;

__device__ __forceinline__ void scan_unit(LAS unsigned char* lds_all, const Ctx& C, int pseq, int h, int mode) {
    const int tid = threadIdx.x, dir = tid >> 8, lane = tid & 63, beta = (tid >> 6) & 3, r = lane & 31, hh = lane >> 5;
    const bool want_out = (mode != 1);
    LAS unsigned char* ldsh = lds_all + dir * SC_HALF;
    const u16* Q = (const u16*)(C.ws + WS_Q); const u16* V = (const u16*)(C.ws + WS_V);
    u16* LF = (u16*)(C.ws + (dir ? WS_LFB : WS_LFF));
    float* SEGF = (float*)(C.ws + WS_HB); float* SEGD = (float*)(C.ws + WS_SEGD);
    const int tok_base = pseq * 256, col0 = h * 128;
    const int a_p = 32 * beta + r, rh = hh;

    f32x16 S[4];
#pragma unroll
    for (int al = 0; al < 4; ++al)
#pragma unroll
        for (int e = 0; e < 16; ++e) S[al][e] = 0.f;
    if (mode == 2) {
        const float* s0 = SEGF + (size_t)(((pseq - 32) * 8 + h) * 2 + dir) * 16384;
#pragma unroll
        for (int al = 0; al < 4; ++al)
#pragma unroll
            for (int e = 0; e < 16; ++e) S[al][e] = s0[(32 * al + rowmap(e, hh)) * 128 + 32 * beta + r];
    }
    float dsum = 0.f;
    u16 rl[16], rq[16] = {}, rv[16];
    const u16* Qb = Q + (size_t)tok_base * D + col0; const u16* Vb = V + (size_t)tok_base * D + col0; u16* LFb = LF + (size_t)tok_base * D + col0;
    const int stepD = dir ? -D : D, prow0 = dir ? 31 - 16 * rh : 16 * rh;
#define SCAN_LOAD(nc) do { const int cidx_ = dir ? 7 - (nc) : (nc); const int o_ = (32 * cidx_ + prow0) * D + a_p; \
        _Pragma("unroll") for (int pp = 0; pp < 16; ++pp) { rl[pp] = LFb[(unsigned)(o_ + pp * stepD)]; if (want_out) rq[pp] = Qb[(unsigned)(o_ + pp * stepD)]; rv[pp] = Vb[(unsigned)(o_ + pp * stepD)]; } } while (0)
#define SCAN_PREP(bufp) do { LAS unsigned char* lb_ = (bufp); float b_[16]; float run_ = 0.f; \
        _Pragma("unroll") for (int pp = 0; pp < 16; ++pp) { run_ += (float)__builtin_bit_cast(_Float16, rl[pp]); b_[pp] = run_; } \
        const float other_ = __shfl_xor(run_, 32, 64), blast_ = run_ + other_, dect_ = __expf(blast_), badd_ = rh ? other_ : 0.f; \
        float kst_[16]; \
        _Pragma("unroll") for (int pp = 0; pp < 16; ++pp) { \
            const float kk_ = 1.f - __expf((float)__builtin_bit_cast(_Float16, rl[pp])); \
            const float eb_ = __expf(b_[pp] + badd_), kin_ = kk_ * __builtin_amdgcn_rcpf(eb_); const int p_ = 16 * rh + pp; \
            if (want_out) { *(LAS u16*)(lb_ + SC_QIN + p_ * 272 + a_p * 2) = f2bf(bf2f(rq[pp]) * eb_); \
                            *(LAS u16*)(lb_ + SC_KIN + p_ * 272 + a_p * 2) = f2bf(kin_); } \
            kst_[pp] = kin_ * dect_; } \
        u32x4 w0_, w1_; \
        w0_.x = cvt_pk_bf16(kst_[0], kst_[1]); w0_.y = cvt_pk_bf16(kst_[2], kst_[3]); w0_.z = cvt_pk_bf16(kst_[4], kst_[5]); w0_.w = cvt_pk_bf16(kst_[6], kst_[7]); \
        w1_.x = cvt_pk_bf16(kst_[8], kst_[9]); w1_.y = cvt_pk_bf16(kst_[10], kst_[11]); w1_.z = cvt_pk_bf16(kst_[12], kst_[13]); w1_.w = cvt_pk_bf16(kst_[14], kst_[15]); \
        *(LAS u32x4*)(lb_ + SC_KST + a_p * 80 + 32 * rh) = w0_; *(LAS u32x4*)(lb_ + SC_KST + a_p * 80 + 32 * rh + 16) = w1_; \
        w0_.x = rv[0] | ((unsigned)rv[1] << 16); w0_.y = rv[2] | ((unsigned)rv[3] << 16); w0_.z = rv[4] | ((unsigned)rv[5] << 16); w0_.w = rv[6] | ((unsigned)rv[7] << 16); \
        w1_.x = rv[8] | ((unsigned)rv[9] << 16); w1_.y = rv[10] | ((unsigned)rv[11] << 16); w1_.z = rv[12] | ((unsigned)rv[13] << 16); w1_.w = rv[14] | ((unsigned)rv[15] << 16); \
        *(LAS u32x4*)(lb_ + SC_VT + a_p * 80 + 32 * rh) = w0_; *(LAS u32x4*)(lb_ + SC_VT + a_p * 80 + 32 * rh + 16) = w1_; \
        if (rh == 0) { ((LAS float*)(lb_ + SC_DEC))[a_p] = dect_; dsum += blast_; } } while (0)
    SCAN_LOAD(0);
    SCAN_PREP(ldsh);
    __syncthreads();
    for (int nchunk = 0; nchunk < 8; ++nchunk) {
        const int cidx = dir ? 7 - nchunk : nchunk;
        LAS unsigned char* lds = ldsh + (nchunk & 1) * SC_BUF;
        if (nchunk < 7) SCAN_LOAD(nchunk + 1);
        if (want_out) {
            f32x16 accP;
#pragma unroll
            for (int e = 0; e < 16; ++e) accP[e] = 0.f;
#pragma unroll
            for (int kk = 0; kk < 8; ++kk) {
                const bf16x8 A = *(const LAS bf16x8*)(lds + SC_KIN + r * 272 + 32 * kk + 16 * hh);
                const bf16x8 B = *(const LAS bf16x8*)(lds + SC_QIN + r * 272 + 32 * kk + 16 * hh);
                accP = mfma32(A, B, accP);
            }
#pragma unroll
            for (int e = 0; e < 16; ++e) if (rowmap(e, hh) > r) accP[e] = 0.f;
            f32x16 acco;
#pragma unroll
            for (int e = 0; e < 16; ++e) acco[e] = 0.f;
#pragma unroll
            for (int st = 0; st < 2; ++st) {
                const bf16x8 Pf = pack8(accP[8 * st], accP[8 * st + 1], accP[8 * st + 2], accP[8 * st + 3], accP[8 * st + 4], accP[8 * st + 5], accP[8 * st + 6], accP[8 * st + 7]);
                const bf16x4 lo = *(const LAS bf16x4*)(lds + SC_VT + (32 * beta + r) * 80 + 32 * st + 8 * hh);
                const bf16x4 hi = *(const LAS bf16x4*)(lds + SC_VT + (32 * beta + r) * 80 + 32 * st + 16 + 8 * hh);
                const bf16x8 Bv = (bf16x8){lo[0], lo[1], lo[2], lo[3], hi[0], hi[1], hi[2], hi[3]};
                acco = mfma32(Pf, Bv, acco);
            }
#pragma unroll
            for (int al = 0; al < 4; ++al)
#pragma unroll
                for (int st = 0; st < 2; ++st) {
                    const bf16x4 lo = *(const LAS bf16x4*)(lds + SC_QIN + r * 272 + (32 * al + 16 * st + 4 * hh) * 2);
                    const bf16x4 hi = *(const LAS bf16x4*)(lds + SC_QIN + r * 272 + (32 * al + 16 * st + 8 + 4 * hh) * 2);
                    const bf16x8 Aq = (bf16x8){lo[0], lo[1], lo[2], lo[3], hi[0], hi[1], hi[2], hi[3]};
                    const bf16x8 Bs = pack8(S[al][8 * st], S[al][8 * st + 1], S[al][8 * st + 2], S[al][8 * st + 3], S[al][8 * st + 4], S[al][8 * st + 5], S[al][8 * st + 6], S[al][8 * st + 7]);
                    acco = mfma32(Aq, Bs, acco);
                }
            { const int ob = (32 * cidx + (dir ? 31 - 4 * hh : 4 * hh)) * D + 32 * beta + r;
#pragma unroll
              for (int e = 0; e < 16; ++e) LFb[(unsigned)(ob + ((e & 3) + 8 * (e >> 2)) * stepD)] = f2bf(acco[e]); }
        }
#pragma unroll
        for (int al = 0; al < 4; ++al) {
#pragma unroll
            for (int q = 0; q < 4; ++q) {
                const f32x4 d4 = *(const LAS f32x4*)(lds + SC_DEC + (32 * al + 8 * q + 4 * hh) * 4);
#pragma unroll
                for (int e = 0; e < 4; ++e) S[al][4 * q + e] *= d4[e];
            }
#pragma unroll
            for (int st = 0; st < 2; ++st) {
                const bf16x8 A = *(const LAS bf16x8*)(lds + SC_KST + (32 * al + r) * 80 + 32 * st + 16 * hh);
                const bf16x8 B = *(const LAS bf16x8*)(lds + SC_VT + (32 * beta + r) * 80 + 32 * st + 16 * hh);
                S[al] = mfma32(A, B, S[al]);
            }
        }
        if (nchunk < 7) SCAN_PREP(ldsh + ((nchunk + 1) & 1) * SC_BUF);
        __syncthreads();
    }
#undef SCAN_LOAD
#undef SCAN_PREP
    if (mode == 0) {
        float* ns = C.out + (size_t)T * D + (size_t)((pseq * 2 + dir) * 8 + h) * 16384;
#pragma unroll
        for (int al = 0; al < 4; ++al)
#pragma unroll
            for (int e = 0; e < 16; ++e) ns[(32 * al + rowmap(e, hh)) * 128 + 32 * beta + r] = S[al][e];
    } else if (mode == 1) {
        const int seg = pseq - 32;
        float* Fp = SEGF + (size_t)((seg * 8 + h) * 2 + dir) * 16384;
#pragma unroll
        for (int al = 0; al < 4; ++al)
#pragma unroll
            for (int e = 0; e < 16; ++e) Fp[(32 * al + rowmap(e, hh)) * 128 + 32 * beta + r] = S[al][e];
        if (rh == 0) SEGD[(size_t)((seg * 8 + h) * 2 + dir) * 128 + a_p] = __expf(dsum);
    }
    if (want_out) {
        __syncthreads();
        const u16* OF = (const u16*)(C.ws + WS_LFF); const u16* OBk = (const u16*)(C.ws + WS_LFB); u16* G = (u16*)(C.ws + WS_G);
        const int l16 = tid & 15, trow = tid >> 4, v0 = 8 * l16;
        const f32x4 nw0 = *(const f32x4*)(C.in[9] + v0), nw1 = *(const f32x4*)(C.in[9] + v0 + 4);
        const float nw[8] = {nw0[0], nw0[1], nw0[2], nw0[3], nw1[0], nw1[1], nw1[2], nw1[3]};
#pragma unroll
        for (int ib = 0; ib < 2; ++ib) {
            u32x4 fv[4], bv[4], gv4[4];
#pragma unroll
            for (int it = 0; it < 4; ++it) { const size_t idx = (size_t)(tok_base + trow + 32 * (4 * ib + it)) * D + col0 + v0;
                fv[it] = *(const u32x4*)(OF + idx); bv[it] = *(const u32x4*)(OBk + idx); gv4[it] = *(const u32x4*)(G + idx); }
#pragma unroll
            for (int it = 0; it < 4; ++it) {
                const size_t idx = (size_t)(tok_base + trow + 32 * (4 * ib + it)) * D + col0 + v0;
                const u32x4 f = fv[it], bk = bv[it], gg = gv4[it];
                float o[8] = {bflo(f.x) + bflo(bk.x), bfhi(f.x) + bfhi(bk.x), bflo(f.y) + bflo(bk.y), bfhi(f.y) + bfhi(bk.y),
                              bflo(f.z) + bflo(bk.z), bfhi(f.z) + bfhi(bk.z), bflo(f.w) + bflo(bk.w), bfhi(f.w) + bfhi(bk.w)};
                const float gv[8] = {bflo(gg.x), bfhi(gg.x), bflo(gg.y), bfhi(gg.y), bflo(gg.z), bfhi(gg.z), bflo(gg.w), bfhi(gg.w)};
                float ss = 0.f;
#pragma unroll
                for (int e = 0; e < 8; ++e) ss += o[e] * o[e];
#pragma unroll
                for (int of = 8; of >= 1; of >>= 1) ss += __shfl_xor(ss, of, 64);
                const float rinv = rsqrtf(ss * (1.f / 128.f) + 1e-6f);
#pragma unroll
                for (int e = 0; e < 8; ++e) o[e] = o[e] * rinv * nw[e] * gv[e];
                u32x4 w; w.x = cvt_pk_bf16(o[0], o[1]); w.y = cvt_pk_bf16(o[2], o[3]); w.z = cvt_pk_bf16(o[4], o[5]); w.w = cvt_pk_bf16(o[6], o[7]);
                *(u32x4*)(G + idx) = w;
            }
        }
    }
    __syncthreads();
}

__device__ __forceinline__ void phase_prefix(const Ctx& C) {
    float* SEGF = (float*)(C.ws + WS_HB); const float* SEGD = (const float*)(C.ws + WS_SEGD);
    for (int v = blockIdx.x * 512 + threadIdx.x; v < 32 * 4096; v += gridDim.x * 512) {
        const int chain = v >> 12, e4 = v & 4095, a = e4 >> 5;
        const int sq = chain >> 4, h = (chain >> 1) & 7, dir = chain & 1;
        f32x4 s = *(const f32x4*)(C.in[2] + (size_t)((sq * 2 + dir) * 8 + h) * 16384 + 4 * e4);
#pragma unroll 8
        for (int i = 0; i < 16; ++i) {
            const int seg = sq * 16 + (dir ? 15 - i : i);
            float* fp = SEGF + (size_t)((seg * 8 + h) * 2 + dir) * 16384 + 4 * e4;
            const f32x4 f = *(const f32x4*)fp; const float d = SEGD[(size_t)((seg * 8 + h) * 2 + dir) * 128 + a];
            *(f32x4*)fp = s;
            s = d * s + f;
        }
    }
}

#define XB_TMO      128
#define XB_XCNT(j)  (256  + 64 * (j))
#define XB_XSUB(j)  (1280 + 64 * (j))
#define XB_XGEN(j)  (2304 + 64 * (j))
#define XB_TOP      3328
#define XB_TOPGEN   3392
#define XCD_BAR_WORDS 3456
#define XB_SPIN_CAP (1u << 18)
__device__ __forceinline__ unsigned xb_ld(unsigned* p)              { return __hip_atomic_load(p, __ATOMIC_RELAXED, __HIP_MEMORY_SCOPE_AGENT); }
__device__ __forceinline__ unsigned xb_add(unsigned* p, unsigned v) { return __hip_atomic_fetch_add(p, v, __ATOMIC_RELAXED, __HIP_MEMORY_SCOPE_AGENT); }
__device__ __forceinline__ unsigned xb_xcc_id() { return (unsigned)__builtin_amdgcn_s_getreg((3 << 11) | 20) & 0xFu; }
#define XB_SPIN(cond, bar) do { unsigned _sp = 0; while (cond) { __builtin_amdgcn_s_sleep(1); \
    if ((++_sp & 255u) == 0u) { if (xb_ld(&(bar)[XB_TMO])) break; if (_sp > XB_SPIN_CAP) { atomicAdd(&(bar)[XB_TMO], 1u); break; } } } } while (0)
struct XcdBarrier { unsigned* bar; unsigned x; volatile LAS unsigned* st; };
__device__ __forceinline__ XcdBarrier xcd_barrier_post(unsigned* bar, volatile LAS unsigned* st) {
    XcdBarrier b; b.bar = bar; b.x = xb_xcc_id(); b.st = st;
    if (threadIdx.x == 0) (void)xb_add(&bar[XB_XCNT(b.x)], 1u);
    return b;
}
__device__ __forceinline__ void xcd_barrier_complete(unsigned* bar, unsigned x, unsigned& nloc, unsigned& nx) {
    const unsigned G = gridDim.x * gridDim.y * gridDim.z;
    unsigned sum, cnt, mine, sp = 0u;
    for (;;) {
        sum = 0u; cnt = 0u; mine = 0u;
#pragma unroll
        for (unsigned j = 0; j < 16; ++j) { const unsigned c = xb_ld(&bar[XB_XCNT(j)]); sum += c; cnt += (c > 0u) ? 1u : 0u; mine = (j == x) ? c : mine; }
        if (sum == G) break;
        __builtin_amdgcn_s_sleep(1);
        if ((++sp & 255u) == 0u) { if (xb_ld(&bar[XB_TMO])) break; if (sp > XB_SPIN_CAP) { atomicAdd(&bar[XB_TMO], 1u); break; } }
    }
    nloc = mine > 0u ? mine : 1u; nx = cnt > 0u ? cnt : 1u;
}
__device__ __forceinline__ void xcd_barrier(const XcdBarrier& b) {
    asm volatile("s_waitcnt vmcnt(0)" ::: "memory");
    __syncthreads();
    if (threadIdx.x == 0) {
        unsigned* bar = b.bar;
        __builtin_amdgcn_s_waitcnt(0);
        unsigned nloc = b.st[0], nx = b.st[1];
        if (nloc == 0u) { xcd_barrier_complete(bar, b.x, nloc, nx); b.st[0] = nloc; b.st[1] = nx; }
        const unsigned old = xb_add(&bar[XB_XSUB(b.x)], 1u);
        const unsigned gen = old / nloc;
        if (old + 1u == (gen + 1u) * nloc) {
            __builtin_amdgcn_fence(__ATOMIC_RELEASE, "agent");
            asm volatile("s_waitcnt vmcnt(0)" ::: "memory");
            const unsigned og = xb_add(&bar[XB_TOP], 1u);
            const unsigned tg = og / nx;
            if (og + 1u == (tg + 1u) * nx) xb_add(&bar[XB_TOPGEN], 1u);
            else XB_SPIN(xb_ld(&bar[XB_TOPGEN]) == tg, bar);
            __builtin_amdgcn_fence(__ATOMIC_ACQUIRE, "agent");
            xb_add(&bar[XB_XGEN(b.x)], 1u);
            asm volatile("s_waitcnt vmcnt(0)" ::: "memory");
        } else {
            XB_SPIN(xb_ld(&bar[XB_XGEN(b.x)]) == gen, bar);
            __builtin_amdgcn_fence(__ATOMIC_ACQUIRE, "agent");
            asm volatile("s_waitcnt vmcnt(0)" ::: "memory");
        }
    }
    __syncthreads();
}

constexpr int N_PHASES = 15;
__global__ void __launch_bounds__(512, 2) mega_fwd(Params P) {
    extern __shared__ __attribute__((aligned(16))) unsigned char lds_raw[];
    LAS unsigned char* lds = (LAS unsigned char*)lds_raw;
    cg::grid_group grid = cg::this_grid();
    Ctx C;
#pragma unroll
    for (int i = 0; i < 30; ++i) C.in[i] = P.in[i];
    C.out = P.out; C.ws = P.ws;
    unsigned char* ws = P.ws;
    const int lo = P.ph_lo, hi = P.ph_hi;
    const int G = gridDim.x, bid = blockIdx.x;
    volatile LAS unsigned* xbw = (volatile LAS unsigned*)(lds + LDS_XB_OFF);
    if (threadIdx.x < 4) xbw[threadIdx.x] = 0u;
    __syncthreads();
    XcdBarrier xbar = xcd_barrier_post((unsigned*)(ws + WS_BAR), xbw);
#ifndef PHM
#define PHM 0x7fff
#endif
#define IN(k) (((PHM >> (k)) & 1) && lo <= (k) && (k) < hi)
#ifndef REPEAT_MASK
#define REPEAT_MASK 0
#endif
#define NREP(k) ((((REPEAT_MASK) >> (k)) & 1) ? 2 : 1)
#define SEAM(k) do { if (IN(k) && IN((k) + 1)) { if (hi > 1000) grid.sync(); else xcd_barrier(xbar); } } while (0)

    if (IN(0)) for (int rep_ = 0; rep_ < NREP(0); ++rep_) { phase_prep(lds, C); }
    SEAM(0);
    if (IN(1)) for (int rep_ = 0; rep_ < NREP(1); ++rep_) { phase_modulate(C); }
    SEAM(1);
    if (IN(2)) for (int rep_ = 0; rep_ < NREP(2); ++rep_) {
        pg8::Gemm g{1024, (size_t)128 * 1024 * 2, (size_t)128 * 1024 * 2};
        pg8::Sched S{}; S.nM = 12; S.nN = 64; S.nwg = 768; S.G = G; S.c = bid; S.kind = 0;
        S.A = (const char*)(ws + WS_WIN) + (size_t)5120 * 2048; S.B = (const char*)(ws + WS_HB); S.tsA = (size_t)256 * 2048; S.tsB = (size_t)256 * 2048;
        EpiBf E{(u16*)(ws + WS_R60), T};
        pg8::gemm_phase<EpiBf>(lds, g, S, E);
    }
    SEAM(2);
    if (IN(3)) for (int rep_ = 0; rep_ < NREP(3); ++rep_) { for (int u = bid; u < 512; u += G) conv_unit(lds, C, u >> 8, u & 255); }
    SEAM(3);
    if (IN(4)) for (int rep_ = 0; rep_ < NREP(4); ++rep_) {
        pg8::Gemm g{1024, (size_t)128 * 1024 * 2, (size_t)128 * 1024 * 2};
        pg8::Sched S{}; S.nM = 64; S.nN = 28; S.nwg = 1792; S.G = G; S.c = bid; S.kind = 1;
        S.A = (const char*)(ws + WS_HB); S.B = (const char*)(ws + WS_WIN); S.tsA = (size_t)256 * 2048; S.tsB = 0;
        EpiIn E; E.out[0] = (u16*)(ws + WS_Q); E.out[1] = (u16*)(ws + WS_LFF); E.out[2] = (u16*)(ws + WS_LFB); E.out[3] = (u16*)(ws + WS_V);
        E.out[4] = (u16*)(ws + WS_G); E.out[5] = (u16*)(ws + WS_GA); E.out[6] = (u16*)((unsigned char*)P.out + 32 * MiB); E.LB = (const float*)(ws + WS_LB);
        pg8::gemm_phase<EpiIn>(lds, g, S, E);
    }
    SEAM(4);
    if (IN(5)) for (int rep_ = 0; rep_ < NREP(5); ++rep_) {
        for (int u = bid; u < 512; u += G) { if (u < 256) scan_unit(lds, C, u >> 3, u & 7, 0); else scan_unit(lds, C, 32 + ((u - 256) >> 3), u & 7, 1); }
    }
    SEAM(5);
    if (IN(6)) { phase_prefix(C); }
    SEAM(6);
    if (IN(7)) for (int rep_ = 0; rep_ < NREP(7); ++rep_) { for (int u = bid; u < 256; u += G) scan_unit(lds, C, 32 + (u >> 3), u & 7, 2); }
    SEAM(7);
    if (IN(8)) for (int rep_ = 0; rep_ < NREP(8); ++rep_) { phase_transpose_ob(lds, C); }
    SEAM(8);
    if (IN(9)) for (int rep_ = 0; rep_ < NREP(9); ++rep_) {
        pg8::Gemm g{1024, (size_t)128 * 1024 * 2, (size_t)128 * 1024 * 2};
        pg8::Sched S{}; S.nM = 64; S.nN = 4; S.nwg = 256; S.G = G; S.c = bid; S.kind = 2;
        S.A = (const char*)(ws + WS_G); S.A2 = (const char*)(ws + WS_LFF); S.B = (const char*)(ws + WS_WPA); S.B2 = (const char*)(ws + WS_WPB); S.tsA = (size_t)256 * 2048; S.tsB = (size_t)256 * 2048;
        EpiMerge E{(const u16*)(ws + WS_GA), (const u16*)((unsigned char*)P.out + 32 * MiB), (u16*)(ws + WS_T1)};
        pg8::gemm_phase<EpiMerge>(lds, g, S, E);
    }
    SEAM(9);
    if (IN(10)) for (int rep_ = 0; rep_ < NREP(10); ++rep_) {
        pg8::Gemm g{1024, (size_t)128 * 1024 * 2, (size_t)128 * 1024 * 2};
        pg8::Sched S{}; S.nM = 64; S.nN = 4; S.nwg = 256; S.G = G; S.c = bid; S.kind = 0;
        S.A = (const char*)(ws + WS_T1); S.B = (const char*)(ws + WS_WOUT); S.tsA = (size_t)256 * 2048; S.tsB = (size_t)256 * 2048;
        EpiRes<false> E{P.in[0], P.in[1], (const float*)(ws + WS_MOD) + 2 * 1024, (u16*)(ws + WS_U1)};
        pg8::gemm_phase<EpiRes<false>>(lds, g, S, E);
    }
    SEAM(10);
    if (IN(11)) for (int rep_ = 0; rep_ < NREP(11); ++rep_) {
        phase_ln<true>(C, (const u16*)(ws + WS_U1), nullptr, (u16*)(ws + WS_X1), P.in[24], P.in[25], (u16*)(ws + WS_HB), 4, 3);
        __syncthreads();
        for (int u = bid; u < 352; u += G) convert_tile4(lds, P.in[26], (u16*)(ws + WS_WFIN), 1024, 2 * DFF, u);
        if (G != 256) for (int u = bid; u < 176; u += G) convert_tile4(lds, P.in[27], (u16*)(ws + WS_WFOUT), DFF, 1024, u);
    }
    SEAM(11);
    if (IN(12)) for (int rep_ = 0; rep_ < NREP(12); ++rep_) {
        pg8::Gemm g{1024, (size_t)128 * 1024 * 2, (size_t)DFF * 1024 * 2};
        pg8::Sched S{}; S.nM = 64; S.nN = 22; S.nwg = 1408; S.G = G; S.c = bid; S.kind = 0;
        S.A = (const char*)(ws + WS_HB); S.B = (const char*)(ws + WS_WFIN); S.tsA = (size_t)256 * 2048; S.tsB = (size_t)128 * 2048;
        EpiGlu E{(u16*)(ws + WS_FF)};
        pg8::gemm_phase<EpiGlu>(lds, g, S, E);
        if (G == 256 && bid >= 128) for (int u = bid - 128; u < 176; u += 128) convert_tile4(lds, P.in[27], (u16*)(ws + WS_WFOUT), DFF, 1024, u);
    }
    SEAM(12);
    if (IN(13)) for (int rep_ = 0; rep_ < NREP(13); ++rep_) {
        pg8::Gemm g{DFF, (size_t)128 * DFF * 2, (size_t)128 * DFF * 2};
        pg8::Sched S{}; S.nM = 64; S.nN = 4; S.nwg = 256; S.G = G; S.c = bid; S.kind = 0;
        S.A = (const char*)(ws + WS_FF); S.B = (const char*)(ws + WS_WFOUT); S.tsA = (size_t)256 * DFF * 2; S.tsB = (size_t)256 * DFF * 2;
        EpiRes<true> E{(const void*)(ws + WS_X1), nullptr, (const float*)(ws + WS_MOD) + 5 * 1024, (u16*)(ws + WS_HB)};
        pg8::gemm_phase<EpiRes<true>>(lds, g, S, E);
    }
    SEAM(13);
    if (IN(14)) for (int rep_ = 0; rep_ < NREP(14); ++rep_) { phase_ln<false>(C, (const u16*)(ws + WS_HB), P.out, nullptr, P.in[28], P.in[29], nullptr, 0, 0); }
#ifdef DEBUG_SANITIZE
    if (lo == 15) {
        const unsigned* w32 = (const unsigned*)P.ws; unsigned* o32 = (unsigned*)P.out;
        const size_t n = (size_t)T * D, nall = n + 8388608;
        for (size_t i = (size_t)bid * 512 + threadIdx.x; i < nall; i += (size_t)G * 512) {
            unsigned w = o32[i];
#ifdef DEBUG_FOLD
            if (i < n) w ^= w32[i] ^ w32[i + n] ^ w32[i + 2 * n] ^ w32[i + 3 * n];
#endif
            float v = __uint_as_float(w); if (!(fabsf(v) < 1e30f)) v = 0.f;
            P.out[i] = v;
        }
    }
#endif
#undef IN
#undef SEAM
}

extern "C" void kernel_launch(void* const* d_in, const int* in_sizes, int n_in, void* d_out, int out_size, void* d_ws, size_t ws_size, hipStream_t stream) {
    static int grid_blocks = 0;
    if (!grid_blocks) {
        int dev = 0, cus = 0, per_cu = 0;
        hipGetDevice(&dev);
        hipDeviceGetAttribute(&cus, hipDeviceAttributeMultiprocessorCount, dev);
        hipFuncSetAttribute((const void*)mega_fwd, hipFuncAttributeMaxDynamicSharedMemorySize, LDS_BYTES);
        hipOccupancyMaxActiveBlocksPerMultiprocessor(&per_cu, (const void*)mega_fwd, 512, LDS_BYTES);
        if (per_cu < 1) { fprintf(stderr, "occupancy query says %d blocks per CU\n", per_cu); per_cu = 1; }
        if (per_cu > 1) per_cu = 1;
        grid_blocks = cus * per_cu;
        (void)hipGetLastError();
    }
    Params p{};
    for (int i = 0; i < 30; ++i) p.in[i] = (const float*)d_in[i];
    p.out = (float*)d_out; p.ws = (unsigned char*)d_ws;
#if SPLIT_LAUNCH
#ifndef PH_END
#define PH_END N_PHASES
#endif
#ifdef DEBUG_SANITIZE
    const int n_launch = 16;
#else
    const int n_launch = PH_END;
#endif
    for (int ph = 0; ph < n_launch; ++ph) {
        if (ph >= PH_END && ph < 15) continue;
        p.ph_lo = ph; p.ph_hi = ph + 1;
        hipLaunchKernelGGL(mega_fwd, dim3(grid_blocks), dim3(512), LDS_BYTES, stream, p);
    }
#else
    p.ph_lo = 0; p.ph_hi = N_PHASES;
    (void)hipMemsetAsync((char*)d_ws + WS_BAR, 0, XCD_BAR_WORDS * sizeof(unsigned), stream);
    void* args[] = {&p};
    hipError_t e = hipLaunchCooperativeKernel((const void*)mega_fwd, dim3(grid_blocks), dim3(512), args, LDS_BYTES, stream);
    if (e != hipSuccess) fprintf(stderr, "cooperative launch failed: %s (grid %d)\n", hipGetErrorString(e), grid_blocks);
#endif
}
```
